# Optimizing an MI355X kernel written in HIP

```python
import math
import jax, jax.numpy as jnp
from jax import lax
import numpy as np

D_MODEL = 1024
BATCH = 4
SEQ = 4096
DEPTH = 4

CHUNK = 64
EPS = 1e-6
CONV_WIDTH = 3
CONV_DIM = D_MODEL // 2
RET_HEADS = 4
RET_HEAD_DIM = (D_MODEL // 2) // RET_HEADS
RET_DIM = RET_HEADS * RET_HEAD_DIM
ROPE_THETA = 10000.0
SB_HEADS = 8
SB_HEAD_DIM = D_MODEL // SB_HEADS
SB_DIM = SB_HEADS * SB_HEAD_DIM
SB_BLOCK = 128
FFN_MULT_OF = 256
D_FF = -(-8 * D_MODEL // (3 * FFN_MULT_OF)) * FFN_MULT_OF
EVEN_IN = 3 * CONV_DIM + 4 * RET_DIM
N_EVEN = (DEPTH + 1) // 2
N_ODD = DEPTH // 2

kernel_name = 'hybrid_conv_retention_stickbreaking_adaln_trunk'


def rms_norm(x, g):
    xf = x.astype(jnp.float32)
    y = xf * lax.rsqrt(jnp.mean(xf * xf, axis=-1, keepdims=True) + EPS)
    return (y * g.astype(jnp.float32)).astype(x.dtype)


def rotary(x, pos):
    dh = x.shape[-1]
    inv_freq = 1.0 / (ROPE_THETA ** (jnp.arange(0, dh, 2, dtype=jnp.float32) / dh))
    ang = pos.astype(jnp.float32)[:, None] * inv_freq[None, :]
    cos = jnp.cos(ang)[None, :, None, :].astype(x.dtype)
    sin = jnp.sin(ang)[None, :, None, :].astype(x.dtype)
    x1, x2 = jnp.split(x, 2, axis=-1)
    return jnp.concatenate([x1 * cos - x2 * sin, x1 * sin + x2 * cos], axis=-1)


def short_gated_conv(b_gate, c_gate, u, conv_w):
    z = c_gate * u
    w = conv_w[:, None, :].astype(z.dtype)
    y = lax.conv_general_dilated(z, w, window_strides=(1,), padding=[(CONV_WIDTH - 1, 0)],
                                 dimension_numbers=('NWC', 'WIO', 'NWC'),
                                 feature_group_count=CONV_DIM)
    return b_gate * y


def retention(q, k, v):
    bsz, s_len, h, dh = q.shape
    n = s_len // CHUNK
    dt = q.dtype
    log_g = jnp.log1p(-jnp.exp2(-5.0 - jnp.arange(h, dtype=jnp.float32)))
    idx = jnp.arange(CHUNK, dtype=jnp.float32)
    intra_dec = jnp.exp(jnp.abs(idx[:, None] - idx[None, :])[None] * log_g[:, None, None]).astype(dt)
    q_dec = jnp.exp((idx + 1.0)[None, :] * log_g[:, None]).astype(dt)
    k_dec = jnp.exp((CHUNK - 1.0 - idx)[None, :] * log_g[:, None]).astype(dt)
    chunk_dec = jnp.exp(CHUNK * log_g).astype(dt)
    qc = q.reshape(bsz, n, CHUNK, h, dh)
    kc = k.reshape(bsz, n, CHUNK, h, dh)
    vc = v.reshape(bsz, n, CHUNK, h, dh)
    scores = jnp.einsum('bnihd,bnjhd->bnhij', qc, kc) * intra_dec
    o_intra = jnp.einsum('bnhij,bnjhd->bnihd', scores, vc)
    kv = jnp.einsum('bnjhd,hj,bnjhe->bnhde', kc, k_dec, vc)

    def step(state, kv_i):
        return state * chunk_dec[None, :, None, None] + kv_i, state

    _, prev = lax.scan(step, jnp.zeros_like(kv[:, 0]), jnp.moveaxis(kv, 1, 0))
    prev = jnp.moveaxis(prev, 0, 1)
    o_inter = jnp.einsum('bnihd,hi,bnhde->bnihe', qc, q_dec, prev)
    return (o_intra + o_inter).reshape(bsz, s_len, h, dh)


def stick_breaking(q, k, v):
    s_len, dh = q.shape[2], q.shape[3]
    scale = dh ** -0.5
    outs = []
    for i in range(s_len // SB_BLOCK):
        q0 = i * SB_BLOCK
        kl = q0 + SB_BLOCK
        qb, kb, vb = q[:, :, q0:kl], k[:, :, :kl], v[:, :, :kl]
        z = jnp.einsum('bhqd,bhkd->bhqk', qb, kb).astype(jnp.float32) * scale
        qpos = q0 + jnp.arange(SB_BLOCK)
        kpos = jnp.arange(kl)
        mask = kpos[None, :] < qpos[:, None]
        log_beta = jax.nn.log_sigmoid(z)
        log_keep = jnp.where(mask, jax.nn.log_sigmoid(-z), 0.0)
        acc = lax.cumsum(log_keep, axis=3, reverse=True) - log_keep
        w = jnp.where(mask, jnp.exp(log_beta + acc), 0.0)
        outs.append(jnp.einsum('bhqk,bhkd->bhqd', w.astype(vb.dtype), vb))
    return jnp.concatenate(outs, axis=2)


def even_mixer(h, w_in, conv_w, ret_norm_g, w_out):
    bsz, s_len, _ = h.shape
    proj = h @ w_in
    cuts = [CONV_DIM, 2 * CONV_DIM, 3 * CONV_DIM, 3 * CONV_DIM + RET_DIM,
            3 * CONV_DIM + 2 * RET_DIM, 3 * CONV_DIM + 3 * RET_DIM]
    b_gate, c_gate, u, q, k, v, g = jnp.split(proj, cuts, axis=-1)
    a_out = short_gated_conv(b_gate, c_gate, u, conv_w)
    pos = jnp.arange(s_len)
    q = rotary(q.reshape(bsz, s_len, RET_HEADS, RET_HEAD_DIM), pos)
    k = rotary(k.reshape(bsz, s_len, RET_HEADS, RET_HEAD_DIM), pos) * (RET_HEAD_DIM ** -0.5)
    v = v.reshape(bsz, s_len, RET_HEADS, RET_HEAD_DIM)
    r = retention(q, k, v)
    r = rms_norm(r, ret_norm_g.reshape(RET_HEADS, RET_HEAD_DIM))
    r = jax.nn.silu(g) * r.reshape(bsz, s_len, RET_DIM)
    return jnp.concatenate([a_out, r], axis=-1) @ w_out


def odd_mixer(h, w_qkv, q_norm_g, k_norm_g, w_out):
    bsz, s_len, _ = h.shape
    q, k, v = jnp.split(h @ w_qkv, 3, axis=-1)
    q = rms_norm(q.reshape(bsz, s_len, SB_HEADS, SB_HEAD_DIM), q_norm_g)
    k = rms_norm(k.reshape(bsz, s_len, SB_HEADS, SB_HEAD_DIM), k_norm_g)
    v = v.reshape(bsz, s_len, SB_HEADS, SB_HEAD_DIM)
    o = stick_breaking(q.transpose(0, 2, 1, 3), k.transpose(0, 2, 1, 3), v.transpose(0, 2, 1, 3))
    return o.transpose(0, 2, 1, 3).reshape(bsz, s_len, SB_DIM) @ w_out


def swiglu(h, w_gate, w_up, w_down):
    return (jax.nn.silu(h @ w_gate) * (h @ w_up)) @ w_down


def setup_inputs(seed: int = 0) -> dict:
    key = jax.random.key(seed)
    ks = jax.random.split(key, 17)

    def nrm(k, shape, fan_in, mult=1.0):
        return jax.random.normal(k, shape, jnp.float32) * (mult * fan_in ** -0.5)

    def gain(k, shape):
        return 1.0 + 0.02 * jax.random.normal(k, shape, jnp.float32)

    return {
        'x': jax.random.normal(ks[0], (BATCH, SEQ, D_MODEL), jnp.float32),
        'c': jax.random.normal(ks[1], (BATCH, D_MODEL), jnp.float32),
        'ada_w': nrm(ks[2], (DEPTH, D_MODEL, 6 * D_MODEL), D_MODEL, 0.5),
        'ada_b': 0.02 * jax.random.normal(ks[3], (DEPTH, 6 * D_MODEL), jnp.float32),
        'norm_mix_g': gain(ks[4], (DEPTH, D_MODEL)),
        'norm_ffn_g': gain(ks[5], (DEPTH, D_MODEL)),
        'ev_w_in': nrm(ks[6], (N_EVEN, D_MODEL, EVEN_IN), D_MODEL),
        'ev_conv_w': nrm(ks[7], (N_EVEN, CONV_WIDTH, CONV_DIM), CONV_WIDTH),
        'ev_ret_norm_g': gain(ks[8], (N_EVEN, RET_DIM)),
        'ev_w_out': nrm(ks[9], (N_EVEN, CONV_DIM + RET_DIM, D_MODEL), CONV_DIM + RET_DIM),
        'od_w_qkv': nrm(ks[10], (N_ODD, D_MODEL, 3 * SB_DIM), D_MODEL),
        'od_q_norm_g': gain(ks[11], (N_ODD, SB_HEAD_DIM)),
        'od_k_norm_g': gain(ks[12], (N_ODD, SB_HEAD_DIM)),
        'od_w_out': nrm(ks[13], (N_ODD, SB_DIM, D_MODEL), SB_DIM),
        'ffn_w_gate': nrm(ks[14], (DEPTH, D_MODEL, D_FF), D_MODEL),
        'ffn_w_up': nrm(ks[15], (DEPTH, D_MODEL, D_FF), D_MODEL),
        'ffn_w_down': nrm(ks[16], (DEPTH, D_FF, D_MODEL), D_FF),
    }


def reference(x, c, ada_w, ada_b, norm_mix_g, norm_ffn_g, ev_w_in, ev_conv_w, ev_ret_norm_g,
              ev_w_out, od_w_qkv, od_q_norm_g, od_k_norm_g, od_w_out, ffn_w_gate, ffn_w_up,
              ffn_w_down):
    c_act = jax.nn.silu(c)
    for l in range(DEPTH):
        mod = c_act @ ada_w[l] + ada_b[l]
        sh1, sc1, g1, sh2, sc2, g2 = [m[:, None, :] for m in jnp.split(mod, 6, axis=-1)]
        h = rms_norm(x, norm_mix_g[l]) * (1 + sc1) + sh1
        j = l // 2
        if l % 2 == 0:
            y = even_mixer(h, ev_w_in[j], ev_conv_w[j], ev_ret_norm_g[j], ev_w_out[j])
        else:
            y = odd_mixer(h, od_w_qkv[j], od_q_norm_g[j], od_k_norm_g[j], od_w_out[j])
        x = x + g1 * y
        h = rms_norm(x, norm_ffn_g[l]) * (1 + sc2) + sh2
        x = x + g2 * swiglu(h, ffn_w_gate[l], ffn_w_up[l], ffn_w_down[l])
    return x
```

```cpp
#include <hip/hip_runtime.h>
#include <hip/hip_cooperative_groups.h>
#include <cstdio>
#include <cstdint>
namespace cg = cooperative_groups;
namespace pg8 {
#define PG8_LAS __attribute__((address_space(3)))
typedef unsigned short bf16_t;
typedef short bf16x8 __attribute__((ext_vector_type(8)));
typedef float f32x4 __attribute__((ext_vector_type(4)));
typedef unsigned u32x4 __attribute__((ext_vector_type(4)));
constexpr int BM = 256, BK = 64, HALF = 128, HTB = HALF * BK * 2  , STAGE_BYTES = 8 * HTB, NXCD = 8, WGM = 8;

__host__ __device__ __forceinline__ int lds_byte(int r, int c) { const int st = (r >> 4) * 2 + (c >> 5), rr = r & 15, cc = c & 31, ob = rr * 64 + cc * 2; return st * 1024 + (ob ^ (((ob >> 9) & 1) << 5)); }
__host__ __device__ __forceinline__ void stage_rc(int b, int& R, int& C) { const int st = b / 1024, sb = b % 1024, swz = sb ^ (((sb >> 9) & 1) << 5); R = (st >> 1) * 16 + swz / 64; C = (st & 1) * 32 + (swz % 64) / 2; }
__host__ __device__ __forceinline__ int perm32(int rho) { const int n = rho >> 4, i = rho & 15; return 8 * (i >> 2) + 4 * n + (i & 3); }

struct Unit { int pm, pn; };
struct Gemm { const bf16_t* A; const bf16_t* Bt; int M, N, K; };

struct StaticOrder {
    int nM, nN, nwg, G, c;
    __host__ __device__ void init(int M, int N, int G_, int c_) { nM = M / BM; nN = N / BM; nwg = nM * nN; G = G_; c = c_; }
    __host__ __device__ bool next(int i, Unit& u) const {
        const long L = (long)i * G + c; if (L >= nwg) return false;
        int wgid = (int)L; { const int q = nwg / NXCD, r = nwg % NXCD, xcd = wgid % NXCD, off = wgid / NXCD; wgid = (xcd < r ? xcd * (q + 1) : r * (q + 1) + (xcd - r) * q) + off; }
        const int nig = WGM * nN, gid = wgid / nig, fm = gid * WGM, gsz = (nM - fm) < WGM ? (nM - fm) : WGM;
        u.pm = fm + ((wgid % nig) % gsz); u.pn = (wgid % nig) / gsz; return true;
    }
    __device__ __forceinline__ void a_ready(const Unit&) const {}
    __device__ __forceinline__ void done(const Unit&) const {}
};

__device__ __forceinline__ unsigned cvt_pk_bf16(float lo, float hi) { unsigned r; asm volatile("v_cvt_pk_bf16_f32 %0, %1, %2" : "=v"(r) : "v"(lo), "v"(hi)); return r; }
typedef float f32x2 __attribute__((ext_vector_type(2)));
__device__ __forceinline__ f32x2 gelu_pk(f32x2 v) {
    const f32x2 av = __builtin_elementwise_abs(v), d = av * 0.2316418882f + 1.0f;
    f32x2 t; t.x = __builtin_amdgcn_rcpf(d.x); t.y = __builtin_amdgcn_rcpf(d.y);
    f32x2 q = t * 0.5307027145f + (-0.7265760135f); q = q * t + 0.7107068705f; q = q * t + (-0.142248368f); q = q * t + 0.127414796f; q = q * t;
    const f32x2 s = (v * v) * (-0.72134752044f);
    f32x2 e; e.x = __builtin_amdgcn_exp2f(s.x); e.y = __builtin_amdgcn_exp2f(s.y);
    const f32x2 m = v * (q * e), r = v - m;
    f32x2 o; o.x = v.x < 0.f ? m.x : r.x; o.y = v.y < 0.f ? m.y : r.y; return o;
}

template <int ACT  > struct EpiBf16 {
    static constexpr bool PERM = true, AFTER_DRAIN = false; static_assert(ACT == 0 || ACT == 1, "EpiBf16: ACT is 0 (none) or 1 (gelu_pk)");
    bf16_t* O; int ldc; const float* bias; int split_cols; size_t split_stride; float scale0;
    __device__ __forceinline__ void operator()(const f32x4 (&acc)[2][2][4][2], const Unit& u, int wr, int wc, int fr, int fq) const {
        const int row0 = u.pm * BM + wr * 64 + fr; int colt = u.pn * BM; bf16_t* base = O;
        float sc = 1.f; if (split_cols) { const int t = colt / split_cols; base += (size_t)t * split_stride; colt -= t * split_cols; if (t == 0) sc = scale0; }
        const int col0 = colt + wc * 32 + 8 * fq, bcol0 = u.pn * BM + wc * 32 + 8 * fq;
        f32x4 bv[2][2];
#pragma unroll
        for (int bj = 0; bj < 2; ++bj)
#pragma unroll
            for (int n = 0; n < 2; ++n) bv[bj][n] = bias ? *(const f32x4*)(bias + bcol0 + bj * HALF + 4 * n) : (f32x4){0.f, 0.f, 0.f, 0.f};
#pragma unroll
        for (int ai = 0; ai < 2; ++ai)
#pragma unroll
            for (int m = 0; m < 4; ++m) { bf16_t* rowp = base + (size_t)(row0 + ai * HALF + m * 16) * ldc + col0;
#pragma unroll
                for (int bj = 0; bj < 2; ++bj) { f32x4 v0 = acc[ai][bj][m][0] + bv[bj][0], v1 = acc[ai][bj][m][1] + bv[bj][1];
                    if (ACT == 1) { f32x2 a = gelu_pk((f32x2){v0[0], v0[1]}), b = gelu_pk((f32x2){v0[2], v0[3]}), c = gelu_pk((f32x2){v1[0], v1[1]}), d = gelu_pk((f32x2){v1[2], v1[3]});
                        v0 = (f32x4){a.x, a.y, b.x, b.y}; v1 = (f32x4){c.x, c.y, d.x, d.y}; }
                    v0 = v0 * sc; v1 = v1 * sc; u32x4 w; w.x = cvt_pk_bf16(v0[0], v0[1]); w.y = cvt_pk_bf16(v0[2], v0[3]); w.z = cvt_pk_bf16(v1[0], v1[1]); w.w = cvt_pk_bf16(v1[2], v1[3]);
                    *(u32x4*)(rowp + bj * HALF) = w; } }
    }
};
typedef __bf16 bf16x2m_t __attribute__((ext_vector_type(2)));
__device__ __forceinline__ unsigned cvt_pk_m(float lo, float hi) { f32x2 v = {lo, hi}; bf16x2m_t b = __builtin_convertvector(v, bf16x2m_t); return __builtin_bit_cast(unsigned, b); }
__device__ __forceinline__ float silu_f(float g) { return g * __builtin_amdgcn_rcpf(1.0f + __expf(-g)); }

struct EpiSwiGLU {
    static constexpr bool PERM = true, AFTER_DRAIN = false;
    bf16_t* O; int ldc;
    __device__ __forceinline__ void operator()(const f32x4 (&acc)[2][2][4][2], const Unit& u, int wr, int wc, int fr, int fq) const {
        const int row0 = u.pm * BM + wr * 64 + fr, col0 = u.pn * HALF + wc * 32 + 8 * fq;
#pragma unroll
        for (int ai = 0; ai < 2; ++ai)
#pragma unroll
            for (int m = 0; m < 4; ++m) {
                bf16_t* rowp = O + (size_t)(row0 + ai * HALF + m * 16) * ldc + col0;
                const f32x4 g0 = acc[ai][0][m][0], g1 = acc[ai][0][m][1], u0 = acc[ai][1][m][0], u1 = acc[ai][1][m][1];
                f32x4 h0, h1;
#pragma unroll
                for (int i = 0; i < 4; ++i) { h0[i] = silu_f(g0[i]) * u0[i]; h1[i] = silu_f(g1[i]) * u1[i]; }
                u32x4 w; w.x = cvt_pk_m(h0[0], h0[1]); w.y = cvt_pk_m(h0[2], h0[3]); w.z = cvt_pk_m(h1[0], h1[1]); w.w = cvt_pk_m(h1[2], h1[3]);
                *(u32x4*)rowp = w;
            }
    }
};

struct EpiResid {
    static constexpr bool PERM = false, AFTER_DRAIN = false;
    const float* base; float* out; const float* gate;
    __device__ __forceinline__ void operator()(const f32x4 (&acc)[2][2][4][2], const Unit& u, int wr, int wc, int fr, int fq) const {
        const int b = u.pm >> 4;
        const int col0 = u.pn * BM + wc * 32 + 4 * fq;
        f32x4 gv[2][2];
#pragma unroll
        for (int bj = 0; bj < 2; ++bj)
#pragma unroll
            for (int n = 0; n < 2; ++n) gv[bj][n] = *(const f32x4*)(gate + (size_t)b * 6144 + col0 + bj * HALF + n * 16);
#pragma unroll
        for (int ai = 0; ai < 2; ++ai)
#pragma unroll
            for (int m = 0; m < 4; ++m) {
                const size_t off = (size_t)(u.pm * BM + ai * HALF + wr * 64 + m * 16 + fr) * 1024 + col0;
#pragma unroll
                for (int bj = 0; bj < 2; ++bj)
#pragma unroll
                    for (int n = 0; n < 2; ++n) {
                        const f32x4 bs = *(const f32x4*)(base + off + bj * HALF + n * 16);
                        *(f32x4*)(out + off + bj * HALF + n * 16) = bs + gv[bj][n] * acc[ai][bj][m][n];
                    }
            }
    }
};

struct EpiQKNorm {
    static constexpr bool PERM = true, AFTER_DRAIN = false;
    bf16_t* O; int ldc; const float* gq; const float* gk; PG8_LAS float* P;
    __device__ __forceinline__ void operator()(const f32x4 (&acc)[2][2][4][2], const Unit& u, int wr, int wc, int fr, int fq) const {
        float s[2][4][2];
#pragma unroll
        for (int ai = 0; ai < 2; ++ai)
#pragma unroll
            for (int m = 0; m < 4; ++m)
#pragma unroll
                for (int bj = 0; bj < 2; ++bj) {
                    const f32x4 a = acc[ai][bj][m][0], b = acc[ai][bj][m][1];
                    float t = (a[0] * a[0] + a[1] * a[1]) + (a[2] * a[2] + a[3] * a[3]) + (b[0] * b[0] + b[1] * b[1]) + (b[2] * b[2] + b[3] * b[3]);
                    t += __shfl_xor(t, 16); t += __shfl_xor(t, 32);
                    if (fq == 0) P[((ai * HALF + wr * 64 + m * 16 + fr) * 2 + bj) * 4 + wc] = t;
                }
        asm volatile("s_waitcnt lgkmcnt(0)" ::: "memory"); __builtin_amdgcn_s_barrier(); asm volatile("" ::: "memory");
#pragma unroll
        for (int ai = 0; ai < 2; ++ai)
#pragma unroll
            for (int m = 0; m < 4; ++m)
#pragma unroll
                for (int bj = 0; bj < 2; ++bj) {
                    const f32x4 q = *(const PG8_LAS f32x4*)(P + ((ai * HALF + wr * 64 + m * 16 + fr) * 2 + bj) * 4);
                    s[ai][m][bj] = __builtin_amdgcn_rsqf(((q[0] + q[1]) + (q[2] + q[3])) * (1.0f / 128.0f) + 1e-6f);
                }
        const float* gain = (u.pn < 4) ? gq : gk;
        const int hc = wc * 32 + 8 * fq;
        const f32x4 ga = *(const f32x4*)(gain + hc), gb = *(const f32x4*)(gain + hc + 4);
        const int row0 = u.pm * BM + wr * 64 + fr, col0 = u.pn * BM + hc;
#pragma unroll
        for (int ai = 0; ai < 2; ++ai)
#pragma unroll
            for (int m = 0; m < 4; ++m) {
                bf16_t* rowp = O + (size_t)(row0 + ai * HALF + m * 16) * ldc + col0;
#pragma unroll
                for (int bj = 0; bj < 2; ++bj) {
                    const f32x4 v0 = acc[ai][bj][m][0] * ga * s[ai][m][bj], v1 = acc[ai][bj][m][1] * gb * s[ai][m][bj];
                    u32x4 w; w.x = cvt_pk_m(v0[0], v0[1]); w.y = cvt_pk_m(v0[2], v0[3]); w.z = cvt_pk_m(v1[0], v1[1]); w.w = cvt_pk_m(v1[2], v1[3]);
                    *(u32x4*)(rowp + bj * HALF) = w;
                }
            }
        asm volatile("s_waitcnt lgkmcnt(0)" ::: "memory");
    }
};

template <class Epi, class Sched, bool ALIGN_EPI = false, bool SP2 = false>
__device__ __forceinline__ void gemm_phase(PG8_LAS unsigned char* lds, const Gemm g, const Sched& S, const Epi& E) {
    const int tid = threadIdx.x, wid = __builtin_amdgcn_readfirstlane(tid >> 6), lane = tid & 63, wr = wid >> 2, wc = wid & 3, fr = lane & 15, fq = lane >> 4;
    const int K = g.K, nt = K / BK;
    unsigned voffA[2], voffB[2];
#pragma unroll
    for (int i = 0; i < 2; ++i) { int R, C; stage_rc(tid * 16 + i * 8192, R, C); const int Rb = Epi::PERM ? ((R & ~31) + perm32(R & 31)) : R;
        voffA[i] = (unsigned)(R * K + C) * 2u; voffB[i] = (unsigned)(Rb * K + C) * 2u; }
    const size_t kstep = (size_t)(BK * 2);
    const size_t hstep = (size_t)HALF * K * 2;
    const size_t tstep = 2 * hstep;
    const unsigned ldsw = (unsigned)wid * 1024u;
    const int aoff = lds_byte(wr * 64 + fr, fq * 8), boff = lds_byte(wc * 32 + fr, fq * 8);
#define PG8_SA(b, h) (((b) * 2 + (h)) * HTB)
#define PG8_SB(b, h) ((4 + (b) * 2 + (h)) * HTB)
#define PG8_STAGE(bufoff, gbase, voff) do { _Pragma("unroll") for (int _i = 0; _i < 2; ++_i) \
        __builtin_amdgcn_global_load_lds((const unsigned*)((const char*)(gbase) + (voff)[_i]), (PG8_LAS unsigned*)(lds + (bufoff) + ldsw + _i * 8192), 16, 0, 0); } while (0)
#define PG8_LDA(dst, b, h) do { _Pragma("unroll") for (int m = 0; m < 4; ++m) _Pragma("unroll") for (int k = 0; k < 2; ++k) dst[m][k] = *(const PG8_LAS bf16x8*)(lds + PG8_SA(b, h) + aoff + m * 2048 + k * 1024); } while (0)
#define PG8_LDB(dst, b, h) do { _Pragma("unroll") for (int n = 0; n < 2; ++n) _Pragma("unroll") for (int k = 0; k < 2; ++k) dst[n][k] = *(const PG8_LAS bf16x8*)(lds + PG8_SB(b, h) + boff + n * 2048 + k * 1024); } while (0)
#define PG8_MMA(ai, bj, At, Bt) do { __builtin_amdgcn_s_setprio(1); _Pragma("unroll") for (int m = 0; m < 4; ++m) _Pragma("unroll") for (int n = 0; n < 2; ++n) _Pragma("unroll") for (int k = 0; k < 2; ++k) \
        acc[ai][bj][m][n] = __builtin_amdgcn_mfma_f32_16x16x32_bf16(Bt[n][k], At[m][k], acc[ai][bj][m][n], 0, 0, 0); __builtin_amdgcn_s_setprio(0); } while (0)
#define PG8_WAIT_V(n) asm volatile("s_waitcnt vmcnt(" #n ")" ::: "memory")
#define PG8_WAIT_L(n) asm volatile("s_waitcnt lgkmcnt(" #n ")" ::: "memory")
#define PG8_BAR __builtin_amdgcn_s_barrier()
#define PG8_SCHED __builtin_amdgcn_sched_barrier(0)
    Unit cur, nxt; int ui = 0;
    if (!S.next(0, cur)) return;
    f32x4 acc[2][2][4][2];
#pragma unroll
    for (int a = 0; a < 2; ++a)
#pragma unroll
        for (int b = 0; b < 2; ++b)
#pragma unroll
            for (int m = 0; m < 4; ++m)
#pragma unroll
                for (int n = 0; n < 2; ++n) acc[a][b][m][n] = (f32x4){0.f, 0.f, 0.f, 0.f};
    bf16x8 At[4][2], B0[2][2], B1[2][2];
    const char* cA = (const char*)g.A + (size_t)cur.pm * tstep; const char* cB = (const char*)g.Bt + (size_t)cur.pn * tstep;
    S.a_ready(cur);
    if constexpr (SP2) {
        PG8_STAGE(PG8_SB(0, 0), cB, voffB); PG8_STAGE(PG8_SB(0, 1), cB + hstep, voffB); PG8_STAGE(PG8_SA(0, 0), cA, voffA); PG8_STAGE(PG8_SA(0, 1), cA + hstep, voffA);
        if (wr == 1) PG8_BAR;
        PG8_WAIT_V(2); PG8_BAR;
        PG8_STAGE(PG8_SB(1, 0), cB + kstep, voffB); PG8_STAGE(PG8_SA(1, 0), cA + kstep, voffA); PG8_STAGE(PG8_SB(1, 1), cB + hstep + kstep, voffB);
        PG8_WAIT_V(6); PG8_BAR;
    } else {
        PG8_STAGE(PG8_SB(0, 0), cB, voffB); PG8_STAGE(PG8_SA(0, 0), cA, voffA); PG8_STAGE(PG8_SB(0, 1), cB + hstep, voffB); PG8_STAGE(PG8_SA(0, 1), cA + hstep, voffA);
        if (wr == 1) PG8_BAR;
        PG8_WAIT_V(4); PG8_BAR;
        PG8_STAGE(PG8_SB(1, 0), cB + kstep, voffB); PG8_STAGE(PG8_SA(1, 0), cA + kstep, voffA); PG8_STAGE(PG8_SB(1, 1), cB + hstep + kstep, voffB);
        PG8_WAIT_V(6); PG8_BAR;
    }
    for (;;) {
        const bool has_next = S.next(ui + 1, nxt);
        const char* nA = has_next ? (const char*)g.A + (size_t)nxt.pm * tstep : cA; const char* nB = has_next ? (const char*)g.Bt + (size_t)nxt.pn * tstep : cB;
        for (int t = 0; t < nt; t += 2) {
            const bool last = (t == nt - 2);
            const char* a1 = cA + (size_t)(t + 1) * kstep;
            const char* a2 = last ? nA : cA + (size_t)(t + 2) * kstep; const char* b2 = last ? nB : cB + (size_t)(t + 2) * kstep;
            const char* a3 = a2 + kstep; const char* b3 = b2 + kstep;
            if (last && has_next) S.a_ready(nxt);
            if constexpr (SP2) {
            PG8_LDB(B0, 0, 0); PG8_LDB(B1, 0, 1); PG8_SCHED; PG8_LDA(At, 0, 0); PG8_STAGE(PG8_SA(1, 1), a1 + hstep, voffA);
            PG8_WAIT_V(8); PG8_WAIT_L(0); PG8_BAR; PG8_MMA(0, 0, At, B0); PG8_MMA(0, 1, At, B1); PG8_BAR; PG8_SCHED;
            PG8_LDA(At, 0, 1); PG8_STAGE(PG8_SB(0, 0), b2, voffB); PG8_STAGE(PG8_SB(0, 1), b2 + hstep, voffB); PG8_STAGE(PG8_SA(0, 0), a2, voffA);
            PG8_WAIT_V(8); PG8_WAIT_L(0); PG8_BAR; PG8_MMA(1, 0, At, B0); PG8_MMA(1, 1, At, B1); PG8_BAR; PG8_SCHED;
            PG8_LDB(B0, 1, 0); PG8_LDB(B1, 1, 1); PG8_SCHED; PG8_LDA(At, 1, 0); PG8_STAGE(PG8_SA(0, 1), a2 + hstep, voffA);
            PG8_WAIT_V(8); PG8_WAIT_L(0); PG8_BAR; PG8_MMA(0, 0, At, B0); PG8_MMA(0, 1, At, B1); PG8_BAR; PG8_SCHED;
            PG8_LDA(At, 1, 1); PG8_STAGE(PG8_SB(1, 0), b3, voffB); PG8_STAGE(PG8_SB(1, 1), b3 + hstep, voffB); PG8_STAGE(PG8_SA(1, 0), a3, voffA);
            PG8_WAIT_V(8); PG8_WAIT_L(0); PG8_BAR; PG8_MMA(1, 0, At, B0); PG8_MMA(1, 1, At, B1); PG8_BAR; PG8_SCHED;
            } else {
            PG8_LDB(B0, 0, 0); PG8_SCHED; PG8_LDA(At, 0, 0); PG8_STAGE(PG8_SA(1, 1), a1 + hstep, voffA);
            PG8_WAIT_L(8); PG8_BAR; PG8_WAIT_L(0); PG8_MMA(0, 0, At, B0); PG8_BAR; PG8_SCHED;
            PG8_LDB(B1, 0, 1); PG8_STAGE(PG8_SB(0, 0), b2, voffB);
            PG8_BAR; PG8_WAIT_L(0); PG8_MMA(0, 1, At, B1); PG8_BAR;
            PG8_LDA(At, 0, 1); PG8_STAGE(PG8_SA(0, 0), a2, voffA);
            PG8_BAR; PG8_WAIT_L(0); PG8_MMA(1, 0, At, B0); PG8_BAR; PG8_SCHED;
            PG8_STAGE(PG8_SB(0, 1), b2 + hstep, voffB);
            PG8_WAIT_V(6); PG8_BAR; PG8_MMA(1, 1, At, B1); PG8_BAR;
            PG8_LDB(B0, 1, 0); PG8_SCHED; PG8_LDA(At, 1, 0); PG8_STAGE(PG8_SA(0, 1), a2 + hstep, voffA);
            PG8_WAIT_L(8); PG8_BAR; PG8_WAIT_L(0); PG8_MMA(0, 0, At, B0); PG8_BAR; PG8_SCHED;
            PG8_LDB(B1, 1, 1); PG8_STAGE(PG8_SB(1, 0), b3, voffB);
            PG8_BAR; PG8_WAIT_L(0); PG8_MMA(0, 1, At, B1); PG8_BAR;
            PG8_LDA(At, 1, 1); PG8_STAGE(PG8_SA(1, 0), a3, voffA);
            PG8_BAR; PG8_WAIT_L(0); PG8_MMA(1, 0, At, B0); PG8_BAR; PG8_SCHED;
            PG8_STAGE(PG8_SB(1, 1), b3 + hstep, voffB);
            PG8_WAIT_V(6); PG8_BAR; PG8_MMA(1, 1, At, B1); PG8_BAR;
            }
        }
        if constexpr (ALIGN_EPI) { if (wr == 0) PG8_BAR; }
        if constexpr (!Epi::AFTER_DRAIN) { E(acc, cur, wr, wc, fr, fq); S.done(cur); }
        if (!has_next) break;
#pragma unroll
        for (int a = 0; a < 2; ++a)
#pragma unroll
            for (int b = 0; b < 2; ++b)
#pragma unroll
                for (int m = 0; m < 4; ++m)
#pragma unroll
                    for (int n = 0; n < 2; ++n) acc[a][b][m][n] = (f32x4){0.f, 0.f, 0.f, 0.f};
        cur = nxt; cA = nA; cB = nB; ++ui;
        if constexpr (ALIGN_EPI) { if (wr == 1) PG8_BAR; }
    }
    PG8_WAIT_V(0);
    if constexpr (!ALIGN_EPI) { if (wr == 0) PG8_BAR; }
    PG8_BAR;
    if constexpr (Epi::AFTER_DRAIN) { E.fused(acc, cur, wr, wc, fr, fq, lds, wid, lane); S.done(cur); }
#undef PG8_SA
#undef PG8_SB
#undef PG8_STAGE
#undef PG8_LDA
#undef PG8_LDB
#undef PG8_MMA
#undef PG8_WAIT_V
#undef PG8_WAIT_L
#undef PG8_BAR
#undef PG8_SCHED
}
}
namespace mk {
using pg8::bf16_t;
typedef short bf16x8 __attribute__((ext_vector_type(8)));
typedef float f32x4 __attribute__((ext_vector_type(4)));
typedef float f32x2 __attribute__((ext_vector_type(2)));
typedef float f32x16 __attribute__((ext_vector_type(16)));
typedef unsigned u32x4 __attribute__((ext_vector_type(4)));
typedef unsigned u32x2 __attribute__((ext_vector_type(2)));
#define LAS __attribute__((address_space(3)))

constexpr int NB = 4, SEQ = 4096, DM = 1024, TOK = NB * SEQ, DFF = 2816, EVIN = 3584, NL = 4;
constexpr float EPS = 1e-6f;
constexpr size_t MiB = 1u << 20;
constexpr size_t WS_CTL = 0, CTL_BYTES = 1 * MiB, WS_MOD = 65536;
constexpr size_t WS_ROPE = 1 * MiB;
constexpr size_t W_EVIN = 3 * MiB;
constexpr size_t W_EVOUT = W_EVIN + 2 * (size_t)EVIN * DM * 2;
constexpr size_t W_ODQKV = W_EVOUT + 2 * (size_t)DM * DM * 2;
constexpr size_t W_ODOUT = W_ODQKV + 2 * (size_t)3 * DM * DM * 2;
constexpr size_t W_GU = W_ODOUT + 2 * (size_t)DM * DM * 2;
constexpr size_t W_DN = W_GU + 4 * (size_t)2 * DFF * DM * 2;
constexpr size_t W_END = W_DN + 4 * (size_t)DFF * DM * 2;
static_assert(W_END == 103 * MiB, "weight map");
constexpr size_t WS_XN = 103 * MiB, WS_PROJ = 135 * MiB, WS_MIX = 247 * MiB, WS_KV = 279 * MiB, WS_ST = 343 * MiB, WS_END = 375 * MiB;
constexpr int LDS_BYTES = 147456, LDS_EXTRA = 131072;

__device__ __forceinline__ float bflo(unsigned w) { return __uint_as_float(w << 16); }
__device__ __forceinline__ float bfhi(unsigned w) { return __uint_as_float(w & 0xffff0000u); }
typedef __bf16 bf16x2_t __attribute__((ext_vector_type(2)));
__device__ __forceinline__ unsigned pk2(float lo, float hi) { f32x2 v = {lo, hi}; bf16x2_t b = __builtin_convertvector(v, bf16x2_t); return __builtin_bit_cast(unsigned, b); }
__device__ __forceinline__ int crow(int r, int hi) { return (r & 3) + 8 * (r >> 2) + 4 * hi; }
#define WG_BARRIER() do { asm volatile("s_waitcnt vmcnt(0) lgkmcnt(0)" ::: "memory"); __builtin_amdgcn_s_barrier(); asm volatile("" ::: "memory"); } while (0)
#define MFMA32(a, b, c) __builtin_amdgcn_mfma_f32_32x32x16_bf16((a), (b), (c), 0, 0, 0)

__constant__ float LOG2G[4] = {-0.04580368961312479f, -0.02272007650008353f, -0.011315313227834146f, -0.005646563141142063f};
__constant__ float DEC64[4] = {0.13108403247847505f, 0.36498652424390743f, 0.6053409914436964f, 0.7784196093554429f};

__device__ __forceinline__ void transpose_item(const float* W, int K, int N, bf16_t* WT, int mode, LAS float* scr, int item, int lane) {
    const int nblk = N / 32, kb = item / nblk, nb = item % nblk, k0 = 64 * kb, n0 = 32 * nb;
    const int r0 = (mode == 0) ? n0 : ((n0 >> 7) * 256 + (n0 & 127) + (mode == 2 ? 128 : 0));
#pragma unroll 8
    for (int i = 0; i < 32; ++i) { const int kk = 2 * i + (lane >> 5); scr[kk * 33 + (lane & 31)] = W[(size_t)(k0 + kk) * N + n0 + (lane & 31)]; }
    asm volatile("s_waitcnt lgkmcnt(0)" ::: "memory");
    const int c = lane & 7;
#pragma unroll
    for (int j = 0; j < 4; ++j) { const int n = (lane >> 3) + 8 * j; const LAS float* s = scr + (8 * c) * 33 + n;
        u32x4 o; o.x = pk2(s[0 * 33], s[1 * 33]); o.y = pk2(s[2 * 33], s[3 * 33]); o.z = pk2(s[4 * 33], s[5 * 33]); o.w = pk2(s[6 * 33], s[7 * 33]);
        *(u32x4*)(WT + (size_t)(r0 + n) * K + k0 + 8 * c) = o; }
    asm volatile("s_waitcnt lgkmcnt(0)" ::: "memory");
}

struct Ptrs {
    const float *x, *c, *ada_w, *ada_b, *norm_mix_g, *norm_ffn_g, *ev_w_in, *ev_conv_w, *ev_ret_norm_g, *ev_w_out, *od_w_qkv, *od_q_norm_g, *od_k_norm_g, *od_w_out, *ffn_w_gate, *ffn_w_up, *ffn_w_down;
};

__device__ __forceinline__ void prologue(const Ptrs& p, unsigned char* ws, LAS unsigned char* lds, int bid, int G, int tid, int wave, int lane) {
    const int gw = bid * 8 + wave, NGW = G * 8;
    float* mod = (float*)(ws + WS_MOD);
    for (int it = bid; it < 4 * 24; it += G) {
        const int cb = it % 24, l = it / 24;
        f32x4 acc[4];
#pragma unroll
        for (int b = 0; b < 4; ++b) acc[b] = (f32x4){0.f, 0.f, 0.f, 0.f};
#pragma unroll 1
        for (int kh = 0; kh < 2; ++kh) {
            const int kbase = wave * 128 + kh * 64;
            float ca[4];
#pragma unroll
            for (int b = 0; b < 4; ++b) { const float cv = p.c[b * DM + kbase + lane]; ca[b] = pg8::silu_f(cv); }
            const float* wp = p.ada_w + ((size_t)l * DM + kbase) * 6144 + cb * 256 + 4 * lane;
#pragma unroll 8
            for (int k = 0; k < 64; ++k) {
                const f32x4 w = *(const f32x4*)(wp + (size_t)k * 6144);
#pragma unroll
                for (int b = 0; b < 4; ++b) { const float cb_ = __shfl(ca[b], k); acc[b] += w * cb_; }
            }
        }
        LAS float* red = (LAS float*)lds;
#pragma unroll
        for (int b = 0; b < 4; ++b) *(LAS f32x4*)(red + (wave * 4 + b) * 256 + 4 * lane) = acc[b];
        WG_BARRIER();
#pragma unroll
        for (int q = 0; q < 2; ++q) {
            const int o = tid + 512 * q, b = o >> 8, col = o & 255;
            float s = p.ada_b[l * 6144 + cb * 256 + col];
#pragma unroll
            for (int w = 0; w < 8; ++w) s += red[(w * 4 + b) * 256 + col];
            mod[((size_t)(l * 4 + b)) * 6144 + cb * 256 + col] = s;
        }
        WG_BARRIER();
    }
    {
        f32x2* rope = (f32x2*)(ws + WS_ROPE);
        for (int e = bid * 512 + tid; e < SEQ * 64; e += G * 512) {
            const int pos = e >> 6, i = e & 63;
            const float inv = __builtin_amdgcn_exp2f(-(float)i * (13.287712379549449f / 64.0f));
            const float ang = (float)pos * inv;
            const float n = rintf(ang * 0.15915494309189535f);
            float r = fmaf(-n, 6.28125f, ang); r = fmaf(-n, 1.9353071795864769e-3f, r);
            rope[e] = (f32x2){__cosf(r), __sinf(r)};
        }
    }
    {
        LAS float* scr = (LAS float*)(lds + wave * 16384);
        constexpr int I_EVIN = 16 * (EVIN / 32), I_SQ = 16 * 32, I_QKV = 16 * 96, I_G = 16 * (DFF / 32), I_D = (DFF / 64) * 32;
        constexpr int NITEMS = 2 * I_EVIN + 2 * I_SQ + 2 * I_QKV + 2 * I_SQ + 4 * I_G + 4 * I_G + 4 * I_D;
        for (int it = gw; it < NITEMS; it += NGW) {
            int r = it;
            if (r < 2 * I_EVIN) { const int j = r / I_EVIN; transpose_item(p.ev_w_in + (size_t)j * DM * EVIN, DM, EVIN, (bf16_t*)(ws + W_EVIN) + (size_t)j * EVIN * DM, 0, scr, r % I_EVIN, lane); continue; } r -= 2 * I_EVIN;
            if (r < 2 * I_SQ) { const int j = r / I_SQ; transpose_item(p.ev_w_out + (size_t)j * DM * DM, DM, DM, (bf16_t*)(ws + W_EVOUT) + (size_t)j * DM * DM, 0, scr, r % I_SQ, lane); continue; } r -= 2 * I_SQ;
            if (r < 2 * I_QKV) { const int j = r / I_QKV; transpose_item(p.od_w_qkv + (size_t)j * DM * 3 * DM, DM, 3 * DM, (bf16_t*)(ws + W_ODQKV) + (size_t)j * 3 * DM * DM, 0, scr, r % I_QKV, lane); continue; } r -= 2 * I_QKV;
            if (r < 2 * I_SQ) { const int j = r / I_SQ; transpose_item(p.od_w_out + (size_t)j * DM * DM, DM, DM, (bf16_t*)(ws + W_ODOUT) + (size_t)j * DM * DM, 0, scr, r % I_SQ, lane); continue; } r -= 2 * I_SQ;
            if (r < 4 * I_G) { const int l = r / I_G; transpose_item(p.ffn_w_gate + (size_t)l * DM * DFF, DM, DFF, (bf16_t*)(ws + W_GU) + (size_t)l * 2 * DFF * DM, 1, scr, r % I_G, lane); continue; } r -= 4 * I_G;
            if (r < 4 * I_G) { const int l = r / I_G; transpose_item(p.ffn_w_up + (size_t)l * DM * DFF, DM, DFF, (bf16_t*)(ws + W_GU) + (size_t)l * 2 * DFF * DM, 2, scr, r % I_G, lane); continue; } r -= 4 * I_G;
            { const int l = r / I_D; transpose_item(p.ffn_w_down + (size_t)l * DFF * DM, DFF, DM, (bf16_t*)(ws + W_DN) + (size_t)l * DM * DFF, 0, scr, r % I_D, lane); }
        }
    }
}

__device__ __forceinline__ void norm_phase(const float* x, bf16_t* XN, const float* g, const float* modl, int shc, int bid, int G, int wave, int lane) {
    const int gw = bid * 8 + wave, NGW = G * 8;
    for (int m = gw; m < TOK; m += NGW) {
        const int b = m / SEQ;
        const f32x4* xr = (const f32x4*)(x + (size_t)m * DM) + lane;
        f32x4 v[4]; float s = 0.f;
#pragma unroll
        for (int j = 0; j < 4; ++j) { v[j] = xr[64 * j]; s += (v[j][0] * v[j][0] + v[j][1] * v[j][1]) + (v[j][2] * v[j][2] + v[j][3] * v[j][3]); }
#pragma unroll
        for (int o = 1; o < 64; o <<= 1) s += __shfl_xor(s, o);
        const float rstd = __builtin_amdgcn_rsqf(s * (1.0f / DM) + EPS);
        const float* mb = modl + (size_t)b * 6144;
        u32x2* o8 = (u32x2*)(XN + (size_t)m * DM) + lane;
#pragma unroll
        for (int j = 0; j < 4; ++j) {
            const int col = 4 * (lane + 64 * j);
            const f32x4 gg = *(const f32x4*)(g + col), sc = *(const f32x4*)(mb + (shc + 1) * 1024 + col), sh = *(const f32x4*)(mb + shc * 1024 + col);
            const f32x4 y = v[j] * rstd * gg * (sc + 1.0f) + sh;
            o8[64 * j] = (u32x2){pk2(y[0], y[1]), pk2(y[2], y[3])};
        }
    }
}

constexpr int LP = 136;

__device__ __forceinline__ void rot8(const u32x4 a1, const u32x4 a2, const f32x2* rp, float fac, u32x4& o1, u32x4& o2) {
    float x1[8], x2[8], y1[8], y2[8];
#pragma unroll
    for (int i = 0; i < 4; ++i) { x1[2 * i] = bflo(a1[i]); x1[2 * i + 1] = bfhi(a1[i]); x2[2 * i] = bflo(a2[i]); x2[2 * i + 1] = bfhi(a2[i]); }
#pragma unroll
    for (int i = 0; i < 4; ++i) {
        const f32x4 cs = *(const f32x4*)(rp + 2 * i);
        y1[2 * i] = (x1[2 * i] * cs[0] - x2[2 * i] * cs[1]) * fac;          y2[2 * i] = (x1[2 * i] * cs[1] + x2[2 * i] * cs[0]) * fac;
        y1[2 * i + 1] = (x1[2 * i + 1] * cs[2] - x2[2 * i + 1] * cs[3]) * fac; y2[2 * i + 1] = (x1[2 * i + 1] * cs[3] + x2[2 * i + 1] * cs[2]) * fac;
    }
#pragma unroll
    for (int i = 0; i < 4; ++i) { o1[i] = pk2(y1[2 * i], y1[2 * i + 1]); o2[i] = pk2(y2[2 * i], y2[2 * i + 1]); }
}

#define GATHER8(dst, base, ROWEXPR, col) do { unsigned _w[4]; _Pragma("unroll") for (int _q = 0; _q < 4; ++_q) { \
        int jj = 2 * _q; const unsigned lo_ = (base)[(ROWEXPR) * LP + (col)]; jj = 2 * _q + 1; const unsigned hi_ = (base)[(ROWEXPR) * LP + (col)]; _w[_q] = lo_ | (hi_ << 16); } \
        dst = __builtin_bit_cast(bf16x8, (u32x4){_w[0], _w[1], _w[2], _w[3]}); } while (0)

__device__ __forceinline__ void evenA_phase(LAS unsigned char* lds, const bf16_t* PROJ, const f32x2* rope, float* KV, bf16_t* MIX, const float* conv_w,
                                            int bid, int G, int tid, int wave, int lane) {
    for (int it = bid; it < TOK / 64; it += G) {
        const int t0 = it * 64, c = tid;
        const float w0 = conv_w[c], w1 = conv_w[512 + c], w2 = conv_w[1024 + c];
        float zm2 = 0.f, zm1 = 0.f;
        if ((t0 % SEQ) != 0) {
            const bf16_t* p2 = PROJ + (size_t)(t0 - 2) * EVIN; const bf16_t* p1 = PROJ + (size_t)(t0 - 1) * EVIN;
            zm2 = bflo(p2[512 + c]) * bflo(p2[1024 + c]); zm1 = bflo(p1[512 + c]) * bflo(p1[1024 + c]);
        }
#pragma unroll 4
        for (int t = 0; t < 64; ++t) {
            const bf16_t* pr = PROJ + (size_t)(t0 + t) * EVIN;
            const float bg = bflo(pr[c]), z = bflo(pr[512 + c]) * bflo(pr[1024 + c]);
            const float y = w0 * zm2 + w1 * zm1 + w2 * z;
            MIX[(size_t)(t0 + t) * DM + c] = (bf16_t)(pk2(bg * y, 0.f) & 0xffffu);
            zm2 = zm1; zm1 = z;
        }
    }
    LAS bf16_t* Kl = (LAS bf16_t*)lds; LAS bf16_t* Vl = Kl + 64 * LP;
    const int l31 = lane & 31, hi = lane >> 5;
    for (int ui = bid; ui < 1024; ui += G) {
        const int b = ui >> 8, n = (ui >> 2) & 63, h = ui & 3;
        const int j = tid >> 3, c8 = tid & 7;
        const bf16_t* rowp = PROJ + (size_t)(b * SEQ + 64 * n + j) * EVIN + h * 128 + 8 * c8;
        const u32x4 k1 = *(const u32x4*)(rowp + 2048), k2 = *(const u32x4*)(rowp + 2048 + 64);
        const u32x4 v1 = *(const u32x4*)(rowp + 2560), v2 = *(const u32x4*)(rowp + 2560 + 64);
        const float fac = 0.08838834764831845f * __builtin_amdgcn_exp2f((float)(63 - j) * LOG2G[h]);
        u32x4 o1, o2; rot8(k1, k2, rope + (size_t)(64 * n + j) * 64 + 8 * c8, fac, o1, o2);
        *(LAS u32x4*)(Kl + j * LP + 8 * c8) = o1; *(LAS u32x4*)(Kl + j * LP + 64 + 8 * c8) = o2;
        *(LAS u32x4*)(Vl + j * LP + 8 * c8) = v1; *(LAS u32x4*)(Vl + j * LP + 64 + 8 * c8) = v2;
        WG_BARRIER();
        const int eblk = (wave & 3) * 32, dbase = (wave >> 2) * 64;
        f32x16 a0 = {}, a1 = {};
#pragma unroll
        for (int ks = 0; ks < 4; ++ks) {
            bf16x8 A, B0, B1;
            GATHER8(A, Vl, (16 * ks + 8 * hi + jj), eblk + l31);
            GATHER8(B0, Kl, (16 * ks + 8 * hi + jj), dbase + l31);
            GATHER8(B1, Kl, (16 * ks + 8 * hi + jj), dbase + 32 + l31);
            a0 = MFMA32(A, B0, a0); a1 = MFMA32(A, B1, a1);
        }
        float* kvp = KV + (size_t)ui * 16384 + dbase + l31;
#pragma unroll
        for (int r = 0; r < 16; ++r) { const int e = eblk + crow(r, hi); kvp[e * 128] = a0[r]; kvp[e * 128 + 32] = a1[r]; }
        WG_BARRIER();
    }
}

__device__ __forceinline__ void scan_phase(const float* KV, bf16_t* ST, int bid, int G, int tid) {
    for (int p = bid * 512 + tid; p < 16 * 8192; p += G * 512) {
        const int bh = p >> 13, idx = (p & 8191) * 2, b = bh >> 2, h = bh & 3;
        const float dec = DEC64[h];
        float s0 = 0.f, s1 = 0.f;
#pragma unroll 8
        for (int n = 0; n < 64; ++n) {
            const size_t off = (size_t)((b * 64 + n) * 4 + h) * 16384 + idx;
            const f32x2 kv = *(const f32x2*)(KV + off);
            *(unsigned*)(ST + off) = pk2(s0, s1);
            s0 = s0 * dec + kv[0]; s1 = s1 * dec + kv[1];
        }
    }
}

__device__ __forceinline__ void evenB_phase(LAS unsigned char* lds, const bf16_t* PROJ, const f32x2* rope, const bf16_t* ST, bf16_t* MIX, const float* retg,
                                            int bid, int G, int tid, int wave, int lane) {
    LAS bf16_t* Ql = (LAS bf16_t*)lds; LAS bf16_t* Kl = Ql + 64 * LP; LAS bf16_t* Vl = Kl + 64 * LP; LAS float* red = (LAS float*)(Vl + 64 * LP);
    const int l31 = lane & 31, hi = lane >> 5;
    for (int ui = bid; ui < 1024; ui += G) {
        const int b = ui >> 8, n = (ui >> 2) & 63, h = ui & 3;
        const float lg = LOG2G[h];
        {
            const int j = tid >> 3, c8 = tid & 7;
            const bf16_t* rowp = PROJ + (size_t)(b * SEQ + 64 * n + j) * EVIN + h * 128 + 8 * c8;
            const u32x4 q1 = *(const u32x4*)(rowp + 1536), q2 = *(const u32x4*)(rowp + 1536 + 64);
            const u32x4 k1 = *(const u32x4*)(rowp + 2048), k2 = *(const u32x4*)(rowp + 2048 + 64);
            const u32x4 v1 = *(const u32x4*)(rowp + 2560), v2 = *(const u32x4*)(rowp + 2560 + 64);
            const f32x2* rp = rope + (size_t)(64 * n + j) * 64 + 8 * c8;
            u32x4 o1, o2;
            rot8(q1, q2, rp, 1.0f, o1, o2);
            *(LAS u32x4*)(Ql + j * LP + 8 * c8) = o1; *(LAS u32x4*)(Ql + j * LP + 64 + 8 * c8) = o2;
            rot8(k1, k2, rp, 0.08838834764831845f, o1, o2);
            *(LAS u32x4*)(Kl + j * LP + 8 * c8) = o1; *(LAS u32x4*)(Kl + j * LP + 64 + 8 * c8) = o2;
            *(LAS u32x4*)(Vl + j * LP + 8 * c8) = v1; *(LAS u32x4*)(Vl + j * LP + 64 + 8 * c8) = v2;
        }
        WG_BARRIER();
        const int eblk = (wave & 3) * 32, iblk = (wave >> 2) * 32;
        f32x16 p0 = {}, p1 = {};
#pragma unroll
        for (int ks = 0; ks < 8; ++ks) {
            const bf16x8 kA0 = *(const LAS bf16x8*)(Kl + l31 * LP + 16 * ks + 8 * hi), kA1 = *(const LAS bf16x8*)(Kl + (32 + l31) * LP + 16 * ks + 8 * hi);
            const bf16x8 qB = *(const LAS bf16x8*)(Ql + (iblk + l31) * LP + 16 * ks + 8 * hi);
            p0 = MFMA32(kA0, qB, p0); p1 = MFMA32(kA1, qB, p1);
        }
        const int i = iblk + l31;
#pragma unroll
        for (int r = 0; r < 16; ++r) {
            const int j0 = crow(r, hi);
            const int d0 = i - j0, d1 = i - 32 - j0;
            p0[r] *= __builtin_amdgcn_exp2f((float)(d0 < 0 ? -d0 : d0) * lg);
            p1[r] *= __builtin_amdgcn_exp2f((float)(d1 < 0 ? -d1 : d1) * lg);
        }
        bf16x8 pk[4];
        pk[0] = __builtin_bit_cast(bf16x8, (u32x4){pk2(p0[0], p0[1]), pk2(p0[2], p0[3]), pk2(p0[4], p0[5]), pk2(p0[6], p0[7])});
        pk[1] = __builtin_bit_cast(bf16x8, (u32x4){pk2(p0[8], p0[9]), pk2(p0[10], p0[11]), pk2(p0[12], p0[13]), pk2(p0[14], p0[15])});
        pk[2] = __builtin_bit_cast(bf16x8, (u32x4){pk2(p1[0], p1[1]), pk2(p1[2], p1[3]), pk2(p1[4], p1[5]), pk2(p1[6], p1[7])});
        pk[3] = __builtin_bit_cast(bf16x8, (u32x4){pk2(p1[8], p1[9]), pk2(p1[10], p1[11]), pk2(p1[12], p1[13]), pk2(p1[14], p1[15])});
        f32x16 oi = {}, ox = {};
#pragma unroll
        for (int m = 0; m < 4; ++m) {
            bf16x8 A;
            GATHER8(A, Vl, (16 * m + (jj & 3) + 8 * (jj >> 2) + 4 * hi), eblk + l31);
            oi = MFMA32(A, pk[m], oi);
        }
        const bf16_t* stp = ST + (size_t)ui * 16384 + (size_t)(eblk + l31) * 128 + 8 * hi;
#pragma unroll
        for (int ks = 0; ks < 8; ++ks) {
            const bf16x8 A = *(const bf16x8*)(stp + 16 * ks);
            const bf16x8 qB = *(const LAS bf16x8*)(Ql + (iblk + l31) * LP + 16 * ks + 8 * hi);
            ox = MFMA32(A, qB, ox);
        }
        const float qd = __builtin_amdgcn_exp2f((float)(i + 1) * lg);
        float ss = 0.f;
#pragma unroll
        for (int r = 0; r < 16; ++r) { oi[r] += qd * ox[r]; ss += oi[r] * oi[r]; }
        ss += __shfl_xor(ss, 32);
        if (hi == 0) red[wave * 32 + l31] = ss;
        WG_BARRIER();
        const int wb = (wave >> 2) * 4;
        const float tot = (red[wb * 32 + l31] + red[(wb + 1) * 32 + l31]) + (red[(wb + 2) * 32 + l31] + red[(wb + 3) * 32 + l31]);
        const float rstd = __builtin_amdgcn_rsqf(tot * (1.0f / 128.0f) + EPS);
        const size_t t = (size_t)(b * SEQ + 64 * n + i);
#pragma unroll
        for (int g4 = 0; g4 < 4; ++g4) {
            const int e = eblk + 8 * g4 + 4 * hi;
            const u32x2 gw = *(const u32x2*)(PROJ + t * EVIN + 3072 + h * 128 + e);
            const f32x4 gn = *(const f32x4*)(retg + h * 128 + e);
            const float g0 = bflo(gw[0]), g1 = bfhi(gw[0]), g2 = bflo(gw[1]), g3 = bfhi(gw[1]);
            const float y0 = oi[4 * g4] * rstd * gn[0] * pg8::silu_f(g0), y1 = oi[4 * g4 + 1] * rstd * gn[1] * pg8::silu_f(g1);
            const float y2 = oi[4 * g4 + 2] * rstd * gn[2] * pg8::silu_f(g2), y3 = oi[4 * g4 + 3] * rstd * gn[3] * pg8::silu_f(g3);
            *(u32x2*)(MIX + t * DM + 512 + h * 128 + e) = (u32x2){pk2(y0, y1), pk2(y2, y3)};
        }
        WG_BARRIER();
    }
}

constexpr int VP = 72;
__device__ __forceinline__ void attn_phase(LAS unsigned char* lds, const bf16_t* QK, const bf16_t* VT, bf16_t* MIX, int bid, int G, int tid, int wave, int lane) {
    LAS bf16_t* Kl = (LAS bf16_t*)lds; LAS bf16_t* Vtl = Kl + 64 * LP; LAS unsigned* flag = (LAS unsigned*)(Vtl + 128 * VP);
    const int l31 = lane & 31, hi = lane >> 5;
    const float scale = 0.08838834764831845f, LOG2E = 1.4426950408889634f, LN2 = 0.6931471805599453f;
    for (int ui = bid; ui < 512; ui += G) {
        const int qb = ui & 15, bh = ui >> 4, b = bh >> 3, h = bh & 7;
        const int q0 = qb * 256, rowbase = b * SEQ;
        const int qrow = q0 + 32 * wave + l31, qmax_w = q0 + 32 * wave + 31;
        bf16x8 qf[8];
#pragma unroll
        for (int d0 = 0; d0 < 8; ++d0) qf[d0] = *(const bf16x8*)(QK + (size_t)(rowbase + qrow) * 2048 + h * 128 + 16 * d0 + 8 * hi);
        f32x16 o[4];
#pragma unroll
        for (int d = 0; d < 4; ++d) o[d] = (f32x16){};
        float carry = 0.f; bool wdone = false;
        if (lane == 0) flag[wave] = 0u;
        const int jmax = 4 * qb + 3;
        for (int j = jmax; j >= 0; --j) {
            WG_BARRIER();
            if (j != jmax) { unsigned all = 1u;
#pragma unroll
                for (int w = 0; w < 8; ++w) all &= flag[w];
                if (all) break; }
#pragma unroll
            for (int i = 0; i < 2; ++i) {
                const int c = tid + 512 * i;
                { const int row = c >> 4, seg = c & 15;
                  *(LAS u32x4*)(Kl + row * LP + 8 * seg) = *(const u32x4*)(QK + (size_t)(rowbase + 64 * j + row) * 2048 + 1024 + h * 128 + 8 * seg); }
                { const int row = c >> 3, seg = c & 7;
                  *(LAS u32x4*)(Vtl + row * VP + 8 * seg) = *(const u32x4*)(VT + (size_t)(h * 128 + row) * TOK + rowbase + 64 * j + 8 * seg); }
            }
            WG_BARRIER();
            if (!wdone && 64 * j <= qmax_w) {
                f32x16 p0 = {}, p1 = {};
#pragma unroll
                for (int d0 = 0; d0 < 8; ++d0) {
                    const bf16x8 kA0 = *(const LAS bf16x8*)(Kl + l31 * LP + 16 * d0 + 8 * hi), kA1 = *(const LAS bf16x8*)(Kl + (32 + l31) * LP + 16 * d0 + 8 * hi);
                    p0 = MFMA32(kA0, qf[d0], p0); p1 = MFMA32(kA1, qf[d0], p1);
                }
                f32x16 lk0, lk1;
                const int keyb = 64 * j + 4 * hi;
#pragma unroll
                for (int r = 0; r < 16; ++r) {
                    const int key = keyb + (r & 3) + 8 * (r >> 2);
                    { const float z = p0[r] * scale; const bool valid = key < qrow;
                      const float sp = fmaxf(z, 0.f) + LN2 * __builtin_amdgcn_logf(1.0f + __builtin_amdgcn_exp2f(-fabsf(z) * LOG2E));
                      lk0[r] = valid ? -sp : 0.f; p0[r] = valid ? (z - sp) : -__builtin_inff(); }
                    { const float z = p1[r] * scale; const bool valid = (key + 32) < qrow;
                      const float sp = fmaxf(z, 0.f) + LN2 * __builtin_amdgcn_logf(1.0f + __builtin_amdgcn_exp2f(-fabsf(z) * LOG2E));
                      lk1[r] = valid ? -sp : 0.f; p1[r] = valid ? (z - sp) : -__builtin_inff(); }
                }
                float run = carry;
#pragma unroll
                for (int pp = 1; pp >= 0; --pp) {
#pragma unroll
                    for (int g = 3; g >= 0; --g) {
                        const float l0 = pp ? lk1[4 * g] : lk0[4 * g], l1 = pp ? lk1[4 * g + 1] : lk0[4 * g + 1], l2 = pp ? lk1[4 * g + 2] : lk0[4 * g + 2], l3 = pp ? lk1[4 * g + 3] : lk0[4 * g + 3];
                        const float gs = (l0 + l1) + (l2 + l3);
                        const float pgs = __shfl_xor(gs, 32);
                        const float off = run + (hi == 0 ? pgs : 0.f);
                        const float A3 = off, A2 = off + l3, A1 = A2 + l2, A0 = A1 + l1;
                        if (pp) { p1[4 * g + 3] = __builtin_amdgcn_exp2f((p1[4 * g + 3] + A3) * LOG2E); p1[4 * g + 2] = __builtin_amdgcn_exp2f((p1[4 * g + 2] + A2) * LOG2E);
                                  p1[4 * g + 1] = __builtin_amdgcn_exp2f((p1[4 * g + 1] + A1) * LOG2E); p1[4 * g] = __builtin_amdgcn_exp2f((p1[4 * g] + A0) * LOG2E); }
                        else    { p0[4 * g + 3] = __builtin_amdgcn_exp2f((p0[4 * g + 3] + A3) * LOG2E); p0[4 * g + 2] = __builtin_amdgcn_exp2f((p0[4 * g + 2] + A2) * LOG2E);
                                  p0[4 * g + 1] = __builtin_amdgcn_exp2f((p0[4 * g + 1] + A1) * LOG2E); p0[4 * g] = __builtin_amdgcn_exp2f((p0[4 * g] + A0) * LOG2E); }
                        run += gs + pgs;
                    }
                }
                carry = run;
                bf16x8 pk[4];
                pk[0] = __builtin_bit_cast(bf16x8, (u32x4){pk2(p0[0], p0[1]), pk2(p0[2], p0[3]), pk2(p0[4], p0[5]), pk2(p0[6], p0[7])});
                pk[1] = __builtin_bit_cast(bf16x8, (u32x4){pk2(p0[8], p0[9]), pk2(p0[10], p0[11]), pk2(p0[12], p0[13]), pk2(p0[14], p0[15])});
                pk[2] = __builtin_bit_cast(bf16x8, (u32x4){pk2(p1[0], p1[1]), pk2(p1[2], p1[3]), pk2(p1[4], p1[5]), pk2(p1[6], p1[7])});
                pk[3] = __builtin_bit_cast(bf16x8, (u32x4){pk2(p1[8], p1[9]), pk2(p1[10], p1[11]), pk2(p1[12], p1[13]), pk2(p1[14], p1[15])});
#pragma unroll
                for (int db = 0; db < 4; ++db)
#pragma unroll
                    for (int m = 0; m < 4; ++m) {
                        const LAS bf16_t* vp = Vtl + (32 * db + l31) * VP + 16 * m + 4 * hi;
                        const u32x2 lo = *(const LAS u32x2*)vp, hi2 = *(const LAS u32x2*)(vp + 8);
                        const bf16x8 vA = __builtin_bit_cast(bf16x8, (u32x4){lo[0], lo[1], hi2[0], hi2[1]});
                        o[db] = MFMA32(vA, pk[m], o[db]);
                    }
                wdone = __all(carry < -90.0f) != 0;
                if (lane == 0) flag[wave] = wdone ? 1u : 0u;
            }
        }
        bf16_t* op = MIX + (size_t)(rowbase + qrow) * DM + h * 128 + 4 * hi;
#pragma unroll
        for (int db = 0; db < 4; ++db)
#pragma unroll
            for (int g4 = 0; g4 < 4; ++g4)
                *(u32x2*)(op + 32 * db + 8 * g4) = (u32x2){pk2(o[db][4 * g4], o[db][4 * g4 + 1]), pk2(o[db][4 * g4 + 2], o[db][4 * g4 + 3])};
        WG_BARRIER();
    }
}

struct Args { const float* in[17]; float* out; unsigned char* ws; };
enum Phase { PH_PROLOGUE = 0, PH_NORM1, PH_GEMM_EVIN, PH_EVENA, PH_SCAN, PH_EVENB, PH_GEMM_QK, PH_GEMM_VT, PH_ATTN, PH_GEMM_OUT, PH_NORM2, PH_GEMM_GU, PH_GEMM_DN };

template <int PH> __device__ __forceinline__ void run_phase(const Args& a, int l, LAS unsigned char* lds) {
    const int tid = threadIdx.x, lane = tid & 63, wave = __builtin_amdgcn_readfirstlane(tid >> 6);
    const int bid = blockIdx.x, G = gridDim.x;
    unsigned char* ws = a.ws;
    float* out = a.out;
    const int jl = l >> 1;
    const float* modl = (const float*)(ws + WS_MOD) + (size_t)l * 4 * 6144;
    const f32x2* rope = (const f32x2*)(ws + WS_ROPE);
    bf16_t* XN = (bf16_t*)(ws + WS_XN); bf16_t* PROJ = (bf16_t*)(ws + WS_PROJ); bf16_t* MIX = (bf16_t*)(ws + WS_MIX);
    float* KV = (float*)(ws + WS_KV); bf16_t* ST = (bf16_t*)(ws + WS_ST);
    const float* xin = (l == 0) ? a.in[0] : out;
    if constexpr (PH == PH_PROLOGUE) {
        Ptrs p;
        p.x = a.in[0]; p.c = a.in[1]; p.ada_w = a.in[2]; p.ada_b = a.in[3]; p.norm_mix_g = a.in[4]; p.norm_ffn_g = a.in[5]; p.ev_w_in = a.in[6]; p.ev_conv_w = a.in[7];
        p.ev_ret_norm_g = a.in[8]; p.ev_w_out = a.in[9]; p.od_w_qkv = a.in[10]; p.od_q_norm_g = a.in[11]; p.od_k_norm_g = a.in[12]; p.od_w_out = a.in[13];
        p.ffn_w_gate = a.in[14]; p.ffn_w_up = a.in[15]; p.ffn_w_down = a.in[16];
        prologue(p, ws, lds, bid, G, tid, wave, lane);
    } else if constexpr (PH == PH_NORM1) {
        norm_phase(xin, XN, a.in[4] + l * DM, modl, 0, bid, G, wave, lane);
    } else if constexpr (PH == PH_GEMM_EVIN) {
        pg8::Gemm g{XN, (const bf16_t*)(ws + W_EVIN) + (size_t)jl * EVIN * DM, TOK, EVIN, DM}; pg8::StaticOrder S; S.init(TOK, EVIN, G, bid);
        pg8::EpiBf16<0> E{PROJ, EVIN, nullptr, 0, 0, 1.f};
        pg8::gemm_phase<pg8::EpiBf16<0>, pg8::StaticOrder, true, true>(lds, g, S, E);
    } else if constexpr (PH == PH_EVENA) {
        evenA_phase(lds, PROJ, rope, KV, MIX, a.in[7] + (size_t)jl * 3 * 512, bid, G, tid, wave, lane);
    } else if constexpr (PH == PH_SCAN) {
        scan_phase(KV, ST, bid, G, tid);
    } else if constexpr (PH == PH_EVENB) {
        evenB_phase(lds, PROJ, rope, ST, MIX, a.in[8] + jl * 512, bid, G, tid, wave, lane);
    } else if constexpr (PH == PH_GEMM_QK) {
        const bf16_t* wqkv_t = (const bf16_t*)(ws + W_ODQKV) + (size_t)jl * 3 * DM * DM;
        pg8::Gemm g{XN, wqkv_t, TOK, 2048, DM}; pg8::StaticOrder S; S.init(TOK, 2048, G, bid);
        pg8::EpiQKNorm E{PROJ, 2048, a.in[11] + jl * 128, a.in[12] + jl * 128, (PG8_LAS float*)(lds + LDS_EXTRA)};
        pg8::gemm_phase<pg8::EpiQKNorm, pg8::StaticOrder, true, true>(lds, g, S, E);
    } else if constexpr (PH == PH_GEMM_VT) {
        const bf16_t* wqkv_t = (const bf16_t*)(ws + W_ODQKV) + (size_t)jl * 3 * DM * DM;
        bf16_t* VT = PROJ + (size_t)TOK * 2048;
        pg8::Gemm g{wqkv_t + (size_t)2048 * DM, XN, DM, TOK, DM}; pg8::StaticOrder S; S.init(DM, TOK, G, bid);
        pg8::EpiBf16<0> E{VT, TOK, nullptr, 0, 0, 1.f};
        pg8::gemm_phase<pg8::EpiBf16<0>, pg8::StaticOrder, true, true>(lds, g, S, E);
    } else if constexpr (PH == PH_ATTN) {
        attn_phase(lds, PROJ, PROJ + (size_t)TOK * 2048, MIX, bid, G, tid, wave, lane);
    } else if constexpr (PH == PH_GEMM_OUT) {
        const bf16_t* wout_t = (l & 1) ? (const bf16_t*)(ws + W_ODOUT) + (size_t)jl * DM * DM : (const bf16_t*)(ws + W_EVOUT) + (size_t)jl * DM * DM;
        pg8::Gemm g{MIX, wout_t, TOK, DM, DM}; pg8::StaticOrder S; S.init(TOK, DM, G, bid);
        pg8::EpiResid E{xin, out, modl + 2 * 1024};
        pg8::gemm_phase<pg8::EpiResid, pg8::StaticOrder, true, true>(lds, g, S, E);
    } else if constexpr (PH == PH_NORM2) {
        norm_phase(out, XN, a.in[5] + l * DM, modl, 3, bid, G, wave, lane);
    } else if constexpr (PH == PH_GEMM_GU) {
        pg8::Gemm g{XN, (const bf16_t*)(ws + W_GU) + (size_t)l * 2 * DFF * DM, TOK, 2 * DFF, DM}; pg8::StaticOrder S; S.init(TOK, 2 * DFF, G, bid);
        pg8::EpiSwiGLU E{PROJ, DFF};
        pg8::gemm_phase<pg8::EpiSwiGLU, pg8::StaticOrder, true, true>(lds, g, S, E);
    } else if constexpr (PH == PH_GEMM_DN) {
        pg8::Gemm g{PROJ, (const bf16_t*)(ws + W_DN) + (size_t)l * DM * DFF, TOK, DM, DFF}; pg8::StaticOrder S; S.init(TOK, DM, G, bid);
        pg8::EpiResid E{out, out, modl + 5 * 1024};
        pg8::gemm_phase<pg8::EpiResid, pg8::StaticOrder, true, true>(lds, g, S, E);
    }
}

template <int PH> __global__ void __launch_bounds__(512, 2) k_phase(Args a, int l) {
    extern __shared__ __attribute__((aligned(16))) unsigned char lds_raw[];
    run_phase<PH>(a, l, (LAS unsigned char*)lds_raw);
}
}

template <int PH> static void launch_phase(const mk::Args& a, int l, hipStream_t stream) {
    static bool attr_set = false;
    if (!attr_set) { (void)hipFuncSetAttribute((const void*)mk::k_phase<PH>, hipFuncAttributeMaxDynamicSharedMemorySize, mk::LDS_BYTES); attr_set = true; }
    hipLaunchKernelGGL(mk::k_phase<PH>, dim3(256), dim3(512), mk::LDS_BYTES, stream, a, l);
}

extern "C" void kernel_launch(void* const* d_in, const int* in_sizes, int n_in, void* d_out, int out_size, void* d_ws, size_t ws_size, hipStream_t stream) {
    if (n_in != 17 || out_size != mk::TOK * mk::DM || ws_size < mk::WS_END) { fprintf(stderr, "kernel_launch: unexpected shapes (n_in %d, out %d, ws %zu)\n", n_in, out_size, ws_size); return; }
    mk::Args a{};
    for (int i = 0; i < 17; ++i) a.in[i] = (const float*)d_in[i];
    a.out = (float*)d_out; a.ws = (unsigned char*)d_ws;
    using namespace mk;
    launch_phase<PH_PROLOGUE>(a, 0, stream);
    for (int l = 0; l < NL; ++l) {
        launch_phase<PH_NORM1>(a, l, stream);
        if ((l & 1) == 0) {
            launch_phase<PH_GEMM_EVIN>(a, l, stream);
            launch_phase<PH_EVENA>(a, l, stream);
            launch_phase<PH_SCAN>(a, l, stream);
            launch_phase<PH_EVENB>(a, l, stream);
        } else {
            launch_phase<PH_GEMM_QK>(a, l, stream);
            launch_phase<PH_GEMM_VT>(a, l, stream);
            launch_phase<PH_ATTN>(a, l, stream);
        }
        launch_phase<PH_GEMM_OUT>(a, l, stream);
        launch_phase<PH_NORM2>(a, l, stream);
        launch_phase<PH_GEMM_GU>(a, l, stream);
        launch_phase<PH_GEMM_DN>(a, l, stream);
    }
}
```

```cpp
#include <hip/hip_runtime.h>
#include <hip/hip_cooperative_groups.h>
#include <cstdio>
#include <cstdint>
namespace cg = cooperative_groups;
namespace pg8 {
#define PG8_LAS __attribute__((address_space(3)))
typedef unsigned short bf16_t;
typedef short bf16x8 __attribute__((ext_vector_type(8)));
typedef float f32x4 __attribute__((ext_vector_type(4)));
typedef unsigned u32x4 __attribute__((ext_vector_type(4)));
constexpr int BM = 256, BK = 64, HALF = 128, HTB = HALF * BK * 2  , STAGE_BYTES = 8 * HTB, NXCD = 8, WGM = 6;

__host__ __device__ __forceinline__ int lds_byte(int r, int c) { const int st = (r >> 4) * 2 + (c >> 5), rr = r & 15, cc = c & 31, ob = rr * 64 + cc * 2; return st * 1024 + (ob ^ (((ob >> 9) & 1) << 5)); }
__host__ __device__ __forceinline__ void stage_rc(int b, int& R, int& C) { const int st = b / 1024, sb = b % 1024, swz = sb ^ (((sb >> 9) & 1) << 5); R = (st >> 1) * 16 + swz / 64; C = (st & 1) * 32 + (swz % 64) / 2; }
__host__ __device__ __forceinline__ int perm32(int rho) { const int n = rho >> 4, i = rho & 15; return 8 * (i >> 2) + 4 * n + (i & 3); }

struct Unit { int pm, pn; };
struct Gemm { const bf16_t* A; const bf16_t* Bt; int M, N, K; };

struct StaticOrder {
    int nM, nN, nwg, G, c;
    __host__ __device__ void init(int M, int N, int G_, int c_) { nM = M / BM; nN = N / BM; nwg = nM * nN; G = G_; c = c_; }
    __host__ __device__ bool next(int i, Unit& u) const {
        const long L = (long)i * G + c; if (L >= nwg) return false;
        int wgid = (int)L; { const int q = nwg / NXCD, r = nwg % NXCD, xcd = wgid % NXCD, off = wgid / NXCD; wgid = (xcd < r ? xcd * (q + 1) : r * (q + 1) + (xcd - r) * q) + off; }
        const int nig = WGM * nN, gid = wgid / nig, fm = gid * WGM, gsz = (nM - fm) < WGM ? (nM - fm) : WGM;
        u.pm = fm + ((wgid % nig) % gsz); u.pn = (wgid % nig) / gsz; return true;
    }
    __device__ __forceinline__ void a_ready(const Unit&) const {}
    __device__ __forceinline__ void done(const Unit&) const {}
};

__device__ __forceinline__ unsigned cvt_pk_bf16(float lo, float hi) { unsigned r; asm volatile("v_cvt_pk_bf16_f32 %0, %1, %2" : "=v"(r) : "v"(lo), "v"(hi)); return r; }
typedef float f32x2 __attribute__((ext_vector_type(2)));
__device__ __forceinline__ f32x2 gelu_pk(f32x2 v) {
    const f32x2 av = __builtin_elementwise_abs(v), d = av * 0.2316418882f + 1.0f;
    f32x2 t; t.x = __builtin_amdgcn_rcpf(d.x); t.y = __builtin_amdgcn_rcpf(d.y);
    f32x2 q = t * 0.5307027145f + (-0.7265760135f); q = q * t + 0.7107068705f; q = q * t + (-0.142248368f); q = q * t + 0.127414796f; q = q * t;
    const f32x2 s = (v * v) * (-0.72134752044f);
    f32x2 e; e.x = __builtin_amdgcn_exp2f(s.x); e.y = __builtin_amdgcn_exp2f(s.y);
    const f32x2 m = v * (q * e), r = v - m;
    f32x2 o; o.x = v.x < 0.f ? m.x : r.x; o.y = v.y < 0.f ? m.y : r.y; return o;
}

template <int ACT  > struct EpiBf16 {
    static constexpr bool PERM = true, AFTER_DRAIN = false; static_assert(ACT == 0 || ACT == 1, "EpiBf16: ACT is 0 (none) or 1 (gelu_pk)");
    bf16_t* O; int ldc; const float* bias; int split_cols; size_t split_stride; float scale0;
    __device__ __forceinline__ void operator()(const f32x4 (&acc)[2][2][4][2], const Unit& u, int wr, int wc, int fr, int fq) const {
        const int row0 = u.pm * BM + wr * 64 + fr; int colt = u.pn * BM; bf16_t* base = O;
        float sc = 1.f; if (split_cols) { const int t = colt / split_cols; base += (size_t)t * split_stride; colt -= t * split_cols; if (t == 0) sc = scale0; }
        const int col0 = colt + wc * 32 + 8 * fq, bcol0 = u.pn * BM + wc * 32 + 8 * fq;
        f32x4 bv[2][2];
#pragma unroll
        for (int bj = 0; bj < 2; ++bj)
#pragma unroll
            for (int n = 0; n < 2; ++n) bv[bj][n] = bias ? *(const f32x4*)(bias + bcol0 + bj * HALF + 4 * n) : (f32x4){0.f, 0.f, 0.f, 0.f};
#pragma unroll
        for (int ai = 0; ai < 2; ++ai)
#pragma unroll
            for (int m = 0; m < 4; ++m) { bf16_t* rowp = base + (size_t)(row0 + ai * HALF + m * 16) * ldc + col0;
#pragma unroll
                for (int bj = 0; bj < 2; ++bj) { f32x4 v0 = acc[ai][bj][m][0] + bv[bj][0], v1 = acc[ai][bj][m][1] + bv[bj][1];
                    if (ACT == 1) { f32x2 a = gelu_pk((f32x2){v0[0], v0[1]}), b = gelu_pk((f32x2){v0[2], v0[3]}), c = gelu_pk((f32x2){v1[0], v1[1]}), d = gelu_pk((f32x2){v1[2], v1[3]});
                        v0 = (f32x4){a.x, a.y, b.x, b.y}; v1 = (f32x4){c.x, c.y, d.x, d.y}; }
                    v0 = v0 * sc; v1 = v1 * sc; u32x4 w; w.x = cvt_pk_bf16(v0[0], v0[1]); w.y = cvt_pk_bf16(v0[2], v0[3]); w.z = cvt_pk_bf16(v1[0], v1[1]); w.w = cvt_pk_bf16(v1[2], v1[3]);
                    *(u32x4*)(rowp + bj * HALF) = w; } }
    }
};
typedef unsigned u32x2 __attribute__((ext_vector_type(2)));
typedef __bf16 bf16x2m_t __attribute__((ext_vector_type(2)));
__device__ __forceinline__ unsigned cvt_pk_m(float lo, float hi) { f32x2 v = {lo, hi}; bf16x2m_t b = __builtin_convertvector(v, bf16x2m_t); return __builtin_bit_cast(unsigned, b); }
__device__ __forceinline__ float silu_f(float g) { return g * __builtin_amdgcn_rcpf(1.0f + __expf(-g)); }

__device__ __forceinline__ float rstd_of(const float* ssq, int row) { return __builtin_amdgcn_rsqf(ssq[row] * (1.0f / 1024.0f) + 1e-6f); }

struct EpiScaleBias {
    static constexpr bool PERM = true, AFTER_DRAIN = false;
    bf16_t* O; int ldc; const float* ssq; const float* shw; int ldshw;
    struct Pre { f32x4 bv[2][2]; float sq[2][4]; };
    __device__ __forceinline__ void prefetch(Pre& p, const Unit& u, int wr, int wc, int fr, int fq) const {
        const int b = u.pm >> 4;
        const int row0 = u.pm * BM + wr * 64 + fr, col0 = u.pn * BM + wc * 32 + 8 * fq;
#pragma unroll
        for (int bj = 0; bj < 2; ++bj)
#pragma unroll
            for (int n = 0; n < 2; ++n) p.bv[bj][n] = *(const f32x4*)(shw + (size_t)b * ldshw + col0 + bj * HALF + 4 * n);
#pragma unroll
        for (int ai = 0; ai < 2; ++ai)
#pragma unroll
            for (int m = 0; m < 4; ++m) p.sq[ai][m] = ssq[row0 + ai * HALF + m * 16];
    }
    __device__ __forceinline__ void operator()(const f32x4 (&acc)[2][2][4][2], const Unit& u, int wr, int wc, int fr, int fq, const Pre& p) const {
        const int row0 = u.pm * BM + wr * 64 + fr, col0 = u.pn * BM + wc * 32 + 8 * fq;
        const f32x4 (&bv)[2][2] = p.bv;
#pragma unroll
        for (int ai = 0; ai < 2; ++ai)
#pragma unroll
            for (int m = 0; m < 4; ++m) {
                const int row = row0 + ai * HALF + m * 16;
                const float r = __builtin_amdgcn_rsqf(p.sq[ai][m] * (1.0f / 1024.0f) + 1e-6f);
                bf16_t* rowp = O + (size_t)row * ldc + col0;
#pragma unroll
                for (int bj = 0; bj < 2; ++bj) {
                    const f32x4 v0 = acc[ai][bj][m][0] * r + bv[bj][0], v1 = acc[ai][bj][m][1] * r + bv[bj][1];
                    u32x4 w; w.x = cvt_pk_m(v0[0], v0[1]); w.y = cvt_pk_m(v0[2], v0[3]); w.z = cvt_pk_m(v1[0], v1[1]); w.w = cvt_pk_m(v1[2], v1[3]);
                    *(u32x4*)(rowp + bj * HALF) = w;
                }
            }
    }
};

struct EpiScaleBiasT {
    static constexpr bool PERM = true, AFTER_DRAIN = false;
    bf16_t* O; int ldc; const float* ssq; const float* shw; int ldshw;
    struct Pre { f32x4 q[2][2]; float bs[2][4]; };
    __device__ __forceinline__ void prefetch(Pre& p, const Unit& u, int wr, int wc, int fr, int fq) const {
        const int b = u.pn >> 4;
        const int row0 = u.pm * BM + wr * 64 + fr, col0 = u.pn * BM + wc * 32 + 8 * fq;
#pragma unroll
        for (int bj = 0; bj < 2; ++bj)
#pragma unroll
            for (int n = 0; n < 2; ++n) p.q[bj][n] = *(const f32x4*)(ssq + col0 + bj * HALF + 4 * n);
#pragma unroll
        for (int ai = 0; ai < 2; ++ai)
#pragma unroll
            for (int m = 0; m < 4; ++m) p.bs[ai][m] = shw[(size_t)b * ldshw + row0 + ai * HALF + m * 16];
    }
    __device__ __forceinline__ void operator()(const f32x4 (&acc)[2][2][4][2], const Unit& u, int wr, int wc, int fr, int fq, const Pre& p) const {
        const int row0 = u.pm * BM + wr * 64 + fr, col0 = u.pn * BM + wc * 32 + 8 * fq;
        f32x4 rv[2][2];
#pragma unroll
        for (int bj = 0; bj < 2; ++bj)
#pragma unroll
            for (int n = 0; n < 2; ++n) {
#pragma unroll
                for (int i = 0; i < 4; ++i) rv[bj][n][i] = __builtin_amdgcn_rsqf(p.q[bj][n][i] * (1.0f / 1024.0f) + 1e-6f); }
#pragma unroll
        for (int ai = 0; ai < 2; ++ai)
#pragma unroll
            for (int m = 0; m < 4; ++m) {
                const int row = row0 + ai * HALF + m * 16;
                const float bs = p.bs[ai][m];
                bf16_t* rowp = O + (size_t)row * ldc + col0;
#pragma unroll
                for (int bj = 0; bj < 2; ++bj) {
                    const f32x4 v0 = acc[ai][bj][m][0] * rv[bj][0] + bs, v1 = acc[ai][bj][m][1] * rv[bj][1] + bs;
                    u32x4 w; w.x = cvt_pk_m(v0[0], v0[1]); w.y = cvt_pk_m(v0[2], v0[3]); w.z = cvt_pk_m(v1[0], v1[1]); w.w = cvt_pk_m(v1[2], v1[3]);
                    *(u32x4*)(rowp + bj * HALF) = w;
                }
            }
    }
};

struct EpiSwiGLU {
    static constexpr bool PERM = true, AFTER_DRAIN = false;
    bf16_t* O; int ldc; const float* ssq; const float* shwg; const float* shwu; int ldshw;
    struct Pre { float sq[2][4]; };
    __device__ __forceinline__ void prefetch(Pre& p, const Unit& u, int wr, int wc, int fr, int fq) const {
        const int row0 = u.pm * BM + wr * 64 + fr;
#pragma unroll
        for (int ai = 0; ai < 2; ++ai)
#pragma unroll
            for (int m = 0; m < 4; ++m) p.sq[ai][m] = ssq[row0 + ai * HALF + m * 16];
    }
    __device__ __forceinline__ void operator()(const f32x4 (&acc)[2][2][4][2], const Unit& u, int wr, int wc, int fr, int fq, const Pre& p) const {
        const int row0 = u.pm * BM + wr * 64 + fr, col0 = u.pn * HALF + wc * 32 + 8 * fq;
        const int b = u.pm >> 4;
        const f32x4 bg0 = *(const f32x4*)(shwg + (size_t)b * ldshw + col0), bg1 = *(const f32x4*)(shwg + (size_t)b * ldshw + col0 + 4);
        const f32x4 bu0 = *(const f32x4*)(shwu + (size_t)b * ldshw + col0), bu1 = *(const f32x4*)(shwu + (size_t)b * ldshw + col0 + 4);
#pragma unroll
        for (int ai = 0; ai < 2; ++ai)
#pragma unroll
            for (int m = 0; m < 4; ++m) {
                const int row = row0 + ai * HALF + m * 16;
                const float r = __builtin_amdgcn_rsqf(p.sq[ai][m] * (1.0f / 1024.0f) + 1e-6f);
                bf16_t* rowp = O + (size_t)row * ldc + col0;
                const f32x4 g0 = acc[ai][0][m][0] * r + bg0, g1 = acc[ai][0][m][1] * r + bg1, u0 = acc[ai][1][m][0] * r + bu0, u1 = acc[ai][1][m][1] * r + bu1;
                const f32x4 t0 = g0 * (-1.4426950408889634f), t1 = g1 * (-1.4426950408889634f);
                f32x4 e0, e1;
#pragma unroll
                for (int i = 0; i < 4; ++i) { e0[i] = __builtin_amdgcn_exp2f(t0[i]); e1[i] = __builtin_amdgcn_exp2f(t1[i]); }
                const f32x4 d0 = e0 + 1.0f, d1 = e1 + 1.0f;
                f32x4 r0, r1;
#pragma unroll
                for (int i = 0; i < 4; ++i) { r0[i] = __builtin_amdgcn_rcpf(d0[i]); r1[i] = __builtin_amdgcn_rcpf(d1[i]); }
                const f32x4 h0 = (g0 * u0) * r0, h1 = (g1 * u1) * r1;
                u32x4 w; w.x = cvt_pk_m(h0[0], h0[1]); w.y = cvt_pk_m(h0[2], h0[3]); w.z = cvt_pk_m(h1[0], h1[1]); w.w = cvt_pk_m(h1[2], h1[3]);
                *(u32x4*)rowp = w;
            }
    }
};

struct EpiResidNext {
    static constexpr bool PERM = true, AFTER_DRAIN = false;
    const float* base; float* out; const float* gate; bf16_t* XN; const float* gnorm; const float* scn; float* ssq; int nxt;
    struct Pre { };
    __device__ __forceinline__ void prefetch(Pre&, const Unit&, int, int, int, int) const {}
    __device__ __forceinline__ void operator()(const f32x4 (&acc)[2][2][4][2], const Unit& u, int wr, int wc, int fr, int fq, const Pre&) const {
        const int b = u.pm >> 4;
        const int col0 = u.pn * BM + wc * 32 + 8 * fq;
        f32x4 gv[2][2], gm[2][2];
#pragma unroll
        for (int bj = 0; bj < 2; ++bj)
#pragma unroll
            for (int n = 0; n < 2; ++n) {
                gv[bj][n] = *(const f32x4*)(gate + (size_t)b * 6144 + col0 + bj * HALF + 4 * n);
                gm[bj][n] = (f32x4){0.f, 0.f, 0.f, 0.f};
                if (nxt) gm[bj][n] = *(const f32x4*)(gnorm + col0 + bj * HALF + 4 * n) * (*(const f32x4*)(scn + (size_t)b * 6144 + col0 + bj * HALF + 4 * n) + 1.0f);
            }
#pragma unroll
        for (int ai = 0; ai < 2; ++ai)
#pragma unroll
            for (int mp = 0; mp < 2; ++mp) {
                f32x4 bs[2][2][2];
#pragma unroll
                for (int mm = 0; mm < 2; ++mm) {
                    const size_t off = (size_t)(u.pm * BM + ai * HALF + wr * 64 + (2 * mp + mm) * 16 + fr) * 1024 + col0;
#pragma unroll
                    for (int bj = 0; bj < 2; ++bj) { bs[mm][bj][0] = *(const f32x4*)(base + off + bj * HALF); bs[mm][bj][1] = *(const f32x4*)(base + off + bj * HALF + 4); }
                }
                float ssm[2];
#pragma unroll
                for (int mm = 0; mm < 2; ++mm) {
                    const int m = 2 * mp + mm;
                    const int row = u.pm * BM + ai * HALF + wr * 64 + m * 16 + fr;
                    const size_t off = (size_t)row * 1024 + col0;
                    float ss = 0.f;
#pragma unroll
                    for (int bj = 0; bj < 2; ++bj) {
                        const f32x4 o0 = bs[mm][bj][0] + gv[bj][0] * acc[ai][bj][m][0], o1 = bs[mm][bj][1] + gv[bj][1] * acc[ai][bj][m][1];
                        *(f32x4*)(out + off + bj * HALF) = o0; *(f32x4*)(out + off + bj * HALF + 4) = o1;
                        if (nxt) {
                            ss += ((o0[0] * o0[0] + o0[1] * o0[1]) + (o0[2] * o0[2] + o0[3] * o0[3])) + ((o1[0] * o1[0] + o1[1] * o1[1]) + (o1[2] * o1[2] + o1[3] * o1[3]));
                            const f32x4 x0 = o0 * gm[bj][0], x1 = o1 * gm[bj][1];
                            u32x4 w; w.x = cvt_pk_m(x0[0], x0[1]); w.y = cvt_pk_m(x0[2], x0[3]); w.z = cvt_pk_m(x1[0], x1[1]); w.w = cvt_pk_m(x1[2], x1[3]);
                            *(u32x4*)(XN + off + bj * HALF) = w;
                        }
                    }
                    ss += __shfl_xor(ss, 16); ss += __shfl_xor(ss, 32); ssm[mm] = ss;
                }
                if (nxt && fq == 0) {
#pragma unroll
                    for (int mm = 0; mm < 2; ++mm) unsafeAtomicAdd(ssq + (u.pm * BM + ai * HALF + wr * 64 + (2 * mp + mm) * 16 + fr), ssm[mm]);
                }
            }
    }
};

template <class Epi, class Sched, bool ALIGN_EPI = false, bool SP2 = false>
__device__ __forceinline__ void gemm_phase(PG8_LAS unsigned char* lds, const Gemm g, const Sched& S, const Epi& E, int tid_in) {
    int tid_ = tid_in; asm volatile("" : "+v"(tid_));
    const int tid = tid_, wid = __builtin_amdgcn_readfirstlane(tid >> 6), lane = tid & 63, wr = wid >> 2, wc = wid & 3, fr = lane & 15, fq = lane >> 4;
    const int K = g.K, nt = K / BK;
    unsigned voffA[2], voffB[2];
#pragma unroll
    for (int i = 0; i < 2; ++i) { int R, C; stage_rc(tid * 16 + i * 8192, R, C); const int Rb = Epi::PERM ? ((R & ~31) + perm32(R & 31)) : R;
        voffA[i] = (unsigned)(R * K + C) * 2u; voffB[i] = (unsigned)(Rb * K + C) * 2u; }
    const size_t kstep = (size_t)(BK * 2);
    const size_t hstep = (size_t)HALF * K * 2;
    const size_t tstep = 2 * hstep;
    const unsigned ldsw = (unsigned)wid * 1024u;
    const int aoff = lds_byte(wr * 64 + fr, fq * 8), boff = lds_byte(wc * 32 + fr, fq * 8);
#define PG8_SA(b, h) (((b) * 2 + (h)) * HTB)
#define PG8_SB(b, h) ((4 + (b) * 2 + (h)) * HTB)
#define PG8_STAGE(bufoff, gbase, voff) do { _Pragma("unroll") for (int _i = 0; _i < 2; ++_i) \
        __builtin_amdgcn_global_load_lds((const unsigned*)((const char*)(gbase) + (voff)[_i]), (PG8_LAS unsigned*)(lds + (bufoff) + ldsw + _i * 8192), 16, 0, 0); } while (0)
#define PG8_LDA(dst, b, h) do { _Pragma("unroll") for (int m = 0; m < 4; ++m) _Pragma("unroll") for (int k = 0; k < 2; ++k) dst[m][k] = *(const PG8_LAS bf16x8*)(lds + PG8_SA(b, h) + aoff + m * 2048 + k * 1024); } while (0)
#define PG8_LDB(dst, b, h) do { _Pragma("unroll") for (int n = 0; n < 2; ++n) _Pragma("unroll") for (int k = 0; k < 2; ++k) dst[n][k] = *(const PG8_LAS bf16x8*)(lds + PG8_SB(b, h) + boff + n * 2048 + k * 1024); } while (0)
#define PG8_MMA(ai, bj, At, Bt) do { __builtin_amdgcn_s_setprio(1); _Pragma("unroll") for (int m = 0; m < 4; ++m) _Pragma("unroll") for (int n = 0; n < 2; ++n) _Pragma("unroll") for (int k = 0; k < 2; ++k) \
        acc[ai][bj][m][n] = __builtin_amdgcn_mfma_f32_16x16x32_bf16(Bt[n][k], At[m][k], acc[ai][bj][m][n], 0, 0, 0); __builtin_amdgcn_s_setprio(0); } while (0)
#define PG8_WAIT_V(n) asm volatile("s_waitcnt vmcnt(" #n ")" ::: "memory")
#define PG8_WAIT_L(n) asm volatile("s_waitcnt lgkmcnt(" #n ")" ::: "memory")
#define PG8_BAR __builtin_amdgcn_s_barrier()
#define PG8_SCHED __builtin_amdgcn_sched_barrier(0)
    Unit cur, nxt; int ui = 0;
    if (!S.next(0, cur)) return;
    f32x4 acc[2][2][4][2];
#pragma unroll
    for (int a = 0; a < 2; ++a)
#pragma unroll
        for (int b = 0; b < 2; ++b)
#pragma unroll
            for (int m = 0; m < 4; ++m)
#pragma unroll
                for (int n = 0; n < 2; ++n) acc[a][b][m][n] = (f32x4){0.f, 0.f, 0.f, 0.f};
    bf16x8 At[4][2], B0[2][2], B1[2][2];
    const char* cA = (const char*)g.A + (size_t)cur.pm * tstep; const char* cB = (const char*)g.Bt + (size_t)cur.pn * tstep;
    S.a_ready(cur);
    if constexpr (SP2) {
        PG8_STAGE(PG8_SB(0, 0), cB, voffB); PG8_STAGE(PG8_SB(0, 1), cB + hstep, voffB); PG8_STAGE(PG8_SA(0, 0), cA, voffA); PG8_STAGE(PG8_SA(0, 1), cA + hstep, voffA);
        if (wr == 1) PG8_BAR;
        PG8_WAIT_V(2); PG8_BAR;
        PG8_STAGE(PG8_SB(1, 0), cB + kstep, voffB); PG8_STAGE(PG8_SA(1, 0), cA + kstep, voffA); PG8_STAGE(PG8_SB(1, 1), cB + hstep + kstep, voffB);
        PG8_WAIT_V(6); PG8_BAR;
    } else {
        PG8_STAGE(PG8_SB(0, 0), cB, voffB); PG8_STAGE(PG8_SA(0, 0), cA, voffA); PG8_STAGE(PG8_SB(0, 1), cB + hstep, voffB); PG8_STAGE(PG8_SA(0, 1), cA + hstep, voffA);
        if (wr == 1) PG8_BAR;
        PG8_WAIT_V(4); PG8_BAR;
        PG8_STAGE(PG8_SB(1, 0), cB + kstep, voffB); PG8_STAGE(PG8_SA(1, 0), cA + kstep, voffA); PG8_STAGE(PG8_SB(1, 1), cB + hstep + kstep, voffB);
        PG8_WAIT_V(6); PG8_BAR;
    }
    for (;;) {
        const bool has_next = S.next(ui + 1, nxt);
        typename Epi::Pre pre; E.prefetch(pre, cur, wr, wc, fr, fq);
        const char* nA = has_next ? (const char*)g.A + (size_t)nxt.pm * tstep : cA; const char* nB = has_next ? (const char*)g.Bt + (size_t)nxt.pn * tstep : cB;
        for (int t = 0; t < nt; t += 2) {
            const bool last = (t == nt - 2);
            const char* a1 = cA + (size_t)(t + 1) * kstep;
            const char* a2 = last ? nA : cA + (size_t)(t + 2) * kstep; const char* b2 = last ? nB : cB + (size_t)(t + 2) * kstep;
            const char* a3 = a2 + kstep; const char* b3 = b2 + kstep;
            if (last && has_next) S.a_ready(nxt);
            if constexpr (SP2) {
            PG8_LDB(B0, 0, 0); PG8_LDB(B1, 0, 1); PG8_SCHED; PG8_LDA(At, 0, 0); PG8_STAGE(PG8_SA(1, 1), a1 + hstep, voffA);
            PG8_WAIT_V(8); PG8_WAIT_L(0); PG8_BAR; PG8_MMA(0, 0, At, B0); PG8_MMA(0, 1, At, B1); PG8_BAR; PG8_SCHED;
            PG8_LDA(At, 0, 1); PG8_STAGE(PG8_SB(0, 0), b2, voffB); PG8_STAGE(PG8_SB(0, 1), b2 + hstep, voffB); PG8_STAGE(PG8_SA(0, 0), a2, voffA);
            PG8_WAIT_V(8); PG8_WAIT_L(0); PG8_BAR; PG8_MMA(1, 0, At, B0); PG8_MMA(1, 1, At, B1); PG8_BAR; PG8_SCHED;
            PG8_LDB(B0, 1, 0); PG8_LDB(B1, 1, 1); PG8_SCHED; PG8_LDA(At, 1, 0); PG8_STAGE(PG8_SA(0, 1), a2 + hstep, voffA);
            PG8_WAIT_V(8); PG8_WAIT_L(0); PG8_BAR; PG8_MMA(0, 0, At, B0); PG8_MMA(0, 1, At, B1); PG8_BAR; PG8_SCHED;
            PG8_LDA(At, 1, 1); PG8_STAGE(PG8_SB(1, 0), b3, voffB); PG8_STAGE(PG8_SB(1, 1), b3 + hstep, voffB); PG8_STAGE(PG8_SA(1, 0), a3, voffA);
            PG8_WAIT_V(8); PG8_WAIT_L(0); PG8_BAR; PG8_MMA(1, 0, At, B0); PG8_MMA(1, 1, At, B1); PG8_BAR; PG8_SCHED;
            } else {
            PG8_LDB(B0, 0, 0); PG8_SCHED; PG8_LDA(At, 0, 0); PG8_STAGE(PG8_SA(1, 1), a1 + hstep, voffA);
            PG8_WAIT_L(8); PG8_BAR; PG8_WAIT_L(0); PG8_MMA(0, 0, At, B0); PG8_BAR; PG8_SCHED;
            PG8_LDB(B1, 0, 1); PG8_STAGE(PG8_SB(0, 0), b2, voffB);
            PG8_BAR; PG8_WAIT_L(0); PG8_MMA(0, 1, At, B1); PG8_BAR;
            PG8_LDA(At, 0, 1); PG8_STAGE(PG8_SA(0, 0), a2, voffA);
            PG8_BAR; PG8_WAIT_L(0); PG8_MMA(1, 0, At, B0); PG8_BAR; PG8_SCHED;
            PG8_STAGE(PG8_SB(0, 1), b2 + hstep, voffB);
            PG8_WAIT_V(6); PG8_BAR; PG8_MMA(1, 1, At, B1); PG8_BAR;
            PG8_LDB(B0, 1, 0); PG8_SCHED; PG8_LDA(At, 1, 0); PG8_STAGE(PG8_SA(0, 1), a2 + hstep, voffA);
            PG8_WAIT_L(8); PG8_BAR; PG8_WAIT_L(0); PG8_MMA(0, 0, At, B0); PG8_BAR; PG8_SCHED;
            PG8_LDB(B1, 1, 1); PG8_STAGE(PG8_SB(1, 0), b3, voffB);
            PG8_BAR; PG8_WAIT_L(0); PG8_MMA(0, 1, At, B1); PG8_BAR;
            PG8_LDA(At, 1, 1); PG8_STAGE(PG8_SA(1, 0), a3, voffA);
            PG8_BAR; PG8_WAIT_L(0); PG8_MMA(1, 0, At, B0); PG8_BAR; PG8_SCHED;
            PG8_STAGE(PG8_SB(1, 1), b3 + hstep, voffB);
            PG8_WAIT_V(6); PG8_BAR; PG8_MMA(1, 1, At, B1); PG8_BAR;
            }
        }
        if constexpr (ALIGN_EPI) { if (wr == 0) PG8_BAR; }
        if constexpr (!Epi::AFTER_DRAIN) { E(acc, cur, wr, wc, fr, fq, pre); S.done(cur); }
        if (!has_next) break;
#pragma unroll
        for (int a = 0; a < 2; ++a)
#pragma unroll
            for (int b = 0; b < 2; ++b)
#pragma unroll
                for (int m = 0; m < 4; ++m)
#pragma unroll
                    for (int n = 0; n < 2; ++n) acc[a][b][m][n] = (f32x4){0.f, 0.f, 0.f, 0.f};
        cur = nxt; cA = nA; cB = nB; ++ui;
        if constexpr (ALIGN_EPI) { if (wr == 1) PG8_BAR; }
    }
    PG8_WAIT_V(0);
    if constexpr (!ALIGN_EPI) { if (wr == 0) PG8_BAR; }
    PG8_BAR;
    if constexpr (Epi::AFTER_DRAIN) { E.fused(acc, cur, wr, wc, fr, fq, lds, wid, lane); S.done(cur); }
#undef PG8_SA
#undef PG8_SB
#undef PG8_STAGE
#undef PG8_LDA
#undef PG8_LDB
#undef PG8_MMA
#undef PG8_WAIT_V
#undef PG8_WAIT_L
#undef PG8_BAR
#undef PG8_SCHED
}
}
namespace mk {
using pg8::bf16_t;
typedef short bf16x8 __attribute__((ext_vector_type(8)));
typedef float f32x4 __attribute__((ext_vector_type(4)));
typedef float f32x2 __attribute__((ext_vector_type(2)));
typedef float f32x16 __attribute__((ext_vector_type(16)));
typedef unsigned u32x4 __attribute__((ext_vector_type(4)));
typedef unsigned u32x2 __attribute__((ext_vector_type(2)));
#define LAS __attribute__((address_space(3)))

constexpr int NB = 4, SEQ = 4096, DM = 1024, TOK = NB * SEQ, DFF = 2816, EVIN = 3584, NL = 4;
constexpr float EPS = 1e-6f;
constexpr size_t MiB = 1u << 20;
constexpr size_t WS_CTL = 0, CTL_BYTES = 1 * MiB, WS_MOD = 65536;
constexpr size_t WS_ROPE = 1 * MiB;
constexpr size_t W_EVIN = 3 * MiB;
constexpr size_t W_EVOUT = W_EVIN + 2 * (size_t)EVIN * DM * 2;
constexpr size_t W_ODQKV = W_EVOUT + 2 * (size_t)DM * DM * 2;
constexpr size_t W_ODOUT = W_ODQKV + 2 * (size_t)3 * DM * DM * 2;
constexpr size_t W_GU = W_ODOUT + 2 * (size_t)DM * DM * 2;
constexpr size_t W_DN = W_GU + 4 * (size_t)2 * DFF * DM * 2;
constexpr size_t W_END = W_DN + 4 * (size_t)DFF * DM * 2;
static_assert(W_END == 103 * MiB, "weight map");
constexpr size_t WS_XN = 103 * MiB, WS_PROJ = 135 * MiB, WS_MIX = 247 * MiB, WS_KV = 279 * MiB, WS_ST = 343 * MiB, WS_SHW = 375 * MiB, WS_SSQ = 376 * MiB, WS_END = 377 * MiB;
constexpr int LDSHW = 3584;
constexpr int LDS_BYTES = 147456, LDS_EXTRA = 131072;

__device__ __forceinline__ float bflo(unsigned w) { return __uint_as_float(w << 16); }
__device__ __forceinline__ float bfhi(unsigned w) { return __uint_as_float(w & 0xffff0000u); }
typedef __bf16 bf16x2_t __attribute__((ext_vector_type(2)));
__device__ __forceinline__ unsigned pk2(float lo, float hi) { f32x2 v = {lo, hi}; bf16x2_t b = __builtin_convertvector(v, bf16x2_t); return __builtin_bit_cast(unsigned, b); }
__device__ __forceinline__ int crow(int r, int hi) { return (r & 3) + 8 * (r >> 2) + 4 * hi; }
#define WG_BARRIER() do { asm volatile("s_waitcnt vmcnt(0) lgkmcnt(0)" ::: "memory"); __builtin_amdgcn_s_barrier(); asm volatile("" ::: "memory"); } while (0)
#define MFMA32(a, b, c) __builtin_amdgcn_mfma_f32_32x32x16_bf16((a), (b), (c), 0, 0, 0)

__constant__ float LOG2G[4] = {-0.04580368961312479f, -0.02272007650008353f, -0.011315313227834146f, -0.005646563141142063f};
__constant__ float DEC64[4] = {0.13108403247847505f, 0.36498652424390743f, 0.6053409914436964f, 0.7784196093554429f};

__device__ __forceinline__ void transpose_item(const float* W, int K, int N, bf16_t* WT, int mode, LAS float* scr, int item, int lane) {
    const int nblk = N / 32, kb = item / nblk, nb = item % nblk, k0 = 64 * kb, n0 = 32 * nb;
    const int r0 = (mode == 0) ? n0 : ((n0 >> 7) * 256 + (n0 & 127) + (mode == 2 ? 128 : 0));
    f32x4 v[8];
    const float* src = W + (size_t)(k0 + (lane >> 3)) * N + n0 + 4 * (lane & 7);
#pragma unroll
    for (int i = 0; i < 8; ++i) v[i] = *(const f32x4*)(src + (size_t)(8 * i) * N);
#pragma unroll
    for (int i = 0; i < 8; ++i) { LAS float* d = scr + ((lane >> 3) + 8 * i) * 33 + 4 * (lane & 7); d[0] = v[i][0]; d[1] = v[i][1]; d[2] = v[i][2]; d[3] = v[i][3]; }
    asm volatile("s_waitcnt lgkmcnt(0)" ::: "memory");
    const int c = lane & 7;
#pragma unroll
    for (int j = 0; j < 4; ++j) { const int n = (lane >> 3) + 8 * j; const LAS float* s = scr + (8 * c) * 33 + n;
        u32x4 o; o.x = pk2(s[0 * 33], s[1 * 33]); o.y = pk2(s[2 * 33], s[3 * 33]); o.z = pk2(s[4 * 33], s[5 * 33]); o.w = pk2(s[6 * 33], s[7 * 33]);
        *(u32x4*)(WT + (size_t)(r0 + n) * K + k0 + 8 * c) = o; }
    asm volatile("s_waitcnt lgkmcnt(0)" ::: "memory");
}

__device__ __forceinline__ void gemv4_item(const float* W, int ldw, const float* kvec, int kstride, bool do_silu, float* out, int ostride, const float* bias, LAS unsigned char* lds, int tid, int wave, int lane) {
    f32x4 acc[4];
#pragma unroll
    for (int b = 0; b < 4; ++b) acc[b] = (f32x4){0.f, 0.f, 0.f, 0.f};
#pragma unroll 1
    for (int kh = 0; kh < 2; ++kh) {
        const int kbase = wave * 128 + kh * 64;
        float ca[4];
#pragma unroll
        for (int b = 0; b < 4; ++b) { const float cv = kvec[(size_t)b * kstride + kbase + lane]; ca[b] = do_silu ? pg8::silu_f(cv) : cv; }
        const float* wp = W + (size_t)kbase * ldw + 4 * lane;
#pragma unroll 8
        for (int k = 0; k < 64; ++k) {
            const f32x4 w = *(const f32x4*)(wp + (size_t)k * ldw);
#pragma unroll
            for (int b = 0; b < 4; ++b) { const float cb_ = __shfl(ca[b], k); acc[b] += w * cb_; }
        }
    }
    LAS float* red = (LAS float*)lds;
#pragma unroll
    for (int b = 0; b < 4; ++b) *(LAS f32x4*)(red + (wave * 4 + b) * 256 + 4 * lane) = acc[b];
    WG_BARRIER();
#pragma unroll
    for (int q = 0; q < 2; ++q) {
        const int o = tid + 512 * q, b = o >> 8, col = o & 255;
        float sum = bias ? bias[col] : 0.f;
#pragma unroll
        for (int w = 0; w < 8; ++w) sum += red[(w * 4 + b) * 256 + col];
        out[(size_t)b * ostride + col] = sum;
    }
    WG_BARRIER();
}

struct Ptrs {
    const float *x, *c, *ada_w, *ada_b, *norm_mix_g, *norm_ffn_g, *ev_w_in, *ev_conv_w, *ev_ret_norm_g, *ev_w_out, *od_w_qkv, *od_q_norm_g, *od_k_norm_g, *od_w_out, *ffn_w_gate, *ffn_w_up, *ffn_w_down;
};

__device__ __forceinline__ void convert_layer(const Ptrs& p, unsigned char* ws, LAS unsigned char* lds, int l, int first, int stride, int wave, int lane) {
    LAS float* scr = (LAS float*)(lds + wave * 16384);
    constexpr int I_EVIN = 16 * (EVIN / 32), I_SQ = 16 * 32, I_QKV = 16 * 96, I_G = 16 * (DFF / 32), I_D = (DFF / 64) * 32;
    const int jl = l >> 1, odd = l & 1;
    const int n_in = odd ? I_QKV : I_EVIN, total = n_in + I_SQ + 2 * I_G + I_D;
    for (int it = first; it < total; it += stride) {
        int r = it;
        if (r < n_in) {
            if (odd) transpose_item(p.od_w_qkv + (size_t)jl * DM * 3 * DM, DM, 3 * DM, (bf16_t*)(ws + W_ODQKV) + (size_t)jl * 3 * DM * DM, 0, scr, r, lane);
            else     transpose_item(p.ev_w_in + (size_t)jl * DM * EVIN, DM, EVIN, (bf16_t*)(ws + W_EVIN) + (size_t)jl * EVIN * DM, 0, scr, r, lane);
            continue; }
        r -= n_in;
        if (r < I_SQ) {
            if (odd) transpose_item(p.od_w_out + (size_t)jl * DM * DM, DM, DM, (bf16_t*)(ws + W_ODOUT) + (size_t)jl * DM * DM, 0, scr, r, lane);
            else     transpose_item(p.ev_w_out + (size_t)jl * DM * DM, DM, DM, (bf16_t*)(ws + W_EVOUT) + (size_t)jl * DM * DM, 0, scr, r, lane);
            continue; }
        r -= I_SQ;
        if (r < I_G) { transpose_item(p.ffn_w_gate + (size_t)l * DM * DFF, DM, DFF, (bf16_t*)(ws + W_GU) + (size_t)l * 2 * DFF * DM, 1, scr, r, lane); continue; } r -= I_G;
        if (r < I_G) { transpose_item(p.ffn_w_up + (size_t)l * DM * DFF, DM, DFF, (bf16_t*)(ws + W_GU) + (size_t)l * 2 * DFF * DM, 2, scr, r, lane); continue; } r -= I_G;
        transpose_item(p.ffn_w_down + (size_t)l * DFF * DM, DFF, DM, (bf16_t*)(ws + W_DN) + (size_t)l * DM * DFF, 0, scr, r, lane);
    }
}

__device__ __forceinline__ void prologue(const Ptrs& p, unsigned char* ws, LAS unsigned char* lds, int bid, int G, int tid, int wave, int lane) {
    const int gw = bid * 8 + wave, NGW = G * 8;
    float* mod = (float*)(ws + WS_MOD);
    for (int it = bid; it < 4 * 24; it += G) {
        const int cb = it % 24, l = it / 24;
        gemv4_item(p.ada_w + (size_t)l * DM * 6144 + cb * 256, 6144, p.c, DM, true, mod + (size_t)l * 4 * 6144 + cb * 256, 6144, p.ada_b + l * 6144 + cb * 256, lds, tid, wave, lane);
    }
    { float* ssq = (float*)(ws + WS_SSQ); for (int e = bid * 512 + tid; e < 8 * TOK; e += G * 512) ssq[e] = 0.f; }
    {
        f32x2* rope = (f32x2*)(ws + WS_ROPE);
        for (int e = bid * 512 + tid; e < SEQ * 64; e += G * 512) {
            const int pos = e >> 6, i = e & 63;
            const float inv = __builtin_amdgcn_exp2f(-(float)i * (13.287712379549449f / 64.0f));
            const float ang = (float)pos * inv;
            const float n = rintf(ang * 0.15915494309189535f);
            float r = fmaf(-n, 6.28125f, ang); r = fmaf(-n, 1.9353071795864769e-3f, r);
            rope[e] = (f32x2){__cosf(r), __sinf(r)};
        }
    }
    if (G > 96) { if (bid >= 96) convert_layer(p, ws, lds, 0, (bid - 96) * 8 + wave, (G - 96) * 8, wave, lane); }
    else convert_layer(p, ws, lds, 0, gw, NGW, wave, lane);
}

__device__ __forceinline__ void norm0_rows(const float* x, bf16_t* XN, const float* g, const float* mod0, float* ssq0, int bid, int G, int wave, int lane) {
    const int gw = bid * 8 + wave, NGW = G * 8;
    for (int m = gw; m < TOK; m += NGW) {
        const int b = m / SEQ;
        const f32x4* xr = (const f32x4*)(x + (size_t)m * DM) + lane;
        f32x4 v[4]; float s = 0.f;
#pragma unroll
        for (int j = 0; j < 4; ++j) { v[j] = xr[64 * j]; s += (v[j][0] * v[j][0] + v[j][1] * v[j][1]) + (v[j][2] * v[j][2] + v[j][3] * v[j][3]); }
#pragma unroll
        for (int o = 1; o < 64; o <<= 1) s += __shfl_xor(s, o);
        if (lane == 0) ssq0[m] = s;
        const float* mb = mod0 + (size_t)b * 6144;
        u32x2* o8 = (u32x2*)(XN + (size_t)m * DM) + lane;
#pragma unroll
        for (int j = 0; j < 4; ++j) {
            const int col = 4 * (lane + 64 * j);
            const f32x4 gg = *(const f32x4*)(g + col), sc = *(const f32x4*)(mb + 1024 + col);
            const f32x4 y = v[j] * gg * (sc + 1.0f);
            o8[64 * j] = (u32x2){pk2(y[0], y[1]), pk2(y[2], y[3])};
        }
    }
}
__device__ __forceinline__ void shw_items(const Ptrs& p, unsigned char* ws, LAS unsigned char* lds, int l_lo, int l_hi, int bid, int G, int tid, int wave, int lane) {
    const float* mod = (const float*)(ws + WS_MOD); float* shw = (float*)(ws + WS_SHW);
    int nit = 0;
    for (int l = l_lo; l < l_hi; ++l) nit += (l & 1) ? 34 : 36;
    for (int it = bid; it < nit; it += G) {
        int r = it, l = l_lo;
        for (;;) { const int nl = (l & 1) ? 34 : 36; if (r < nl) break; r -= nl; ++l; }
        const int nmix = (l & 1) ? 12 : 14, jl = l >> 1;
        const float* W; int ldw, which, cb, chunk;
        if (r < nmix) { which = 0; cb = r; chunk = 0; if (l & 1) { W = p.od_w_qkv + (size_t)jl * DM * 3 * DM; ldw = 3 * DM; } else { W = p.ev_w_in + (size_t)jl * DM * EVIN; ldw = EVIN; } }
        else if (r < nmix + 11) { which = 1; cb = r - nmix; chunk = 3; W = p.ffn_w_gate + (size_t)l * DM * DFF; ldw = DFF; }
        else { which = 2; cb = r - nmix - 11; chunk = 3; W = p.ffn_w_up + (size_t)l * DM * DFF; ldw = DFF; }
        gemv4_item(W + cb * 256, ldw, mod + (size_t)l * 4 * 6144 + chunk * 1024, 6144, false, shw + ((size_t)(l * 3 + which) * 4) * LDSHW + cb * 256, LDSHW, nullptr, lds, tid, wave, lane);
    }
}

constexpr int LP = 136;

__device__ __forceinline__ void rot8(const u32x4 a1, const u32x4 a2, const f32x2* rp, float fac, u32x4& o1, u32x4& o2) {
    float x1[8], x2[8], y1[8], y2[8];
#pragma unroll
    for (int i = 0; i < 4; ++i) { x1[2 * i] = bflo(a1[i]); x1[2 * i + 1] = bfhi(a1[i]); x2[2 * i] = bflo(a2[i]); x2[2 * i + 1] = bfhi(a2[i]); }
#pragma unroll
    for (int i = 0; i < 4; ++i) {
        const f32x4 cs = *(const f32x4*)(rp + 2 * i);
        y1[2 * i] = (x1[2 * i] * cs[0] - x2[2 * i] * cs[1]) * fac;          y2[2 * i] = (x1[2 * i] * cs[1] + x2[2 * i] * cs[0]) * fac;
        y1[2 * i + 1] = (x1[2 * i + 1] * cs[2] - x2[2 * i + 1] * cs[3]) * fac; y2[2 * i + 1] = (x1[2 * i + 1] * cs[3] + x2[2 * i + 1] * cs[2]) * fac;
    }
#pragma unroll
    for (int i = 0; i < 4; ++i) { o1[i] = pk2(y1[2 * i], y1[2 * i + 1]); o2[i] = pk2(y2[2 * i], y2[2 * i + 1]); }
}

#define GATHER8(dst, base, ROWEXPR, col) do { unsigned _w[4]; _Pragma("unroll") for (int _q = 0; _q < 4; ++_q) { \
        int jj = 2 * _q; const unsigned lo_ = (base)[(ROWEXPR) * LP + (col)]; jj = 2 * _q + 1; const unsigned hi_ = (base)[(ROWEXPR) * LP + (col)]; _w[_q] = lo_ | (hi_ << 16); } \
        dst = __builtin_bit_cast(bf16x8, (u32x4){_w[0], _w[1], _w[2], _w[3]}); } while (0)

__device__ __forceinline__ void evenA_phase(LAS unsigned char* lds, const bf16_t* PROJ, const f32x2* rope, float* KV, bf16_t* MIX, const float* conv_w,
                                            int bid, int G, int tid, int wave, int lane) {
    for (int it = bid; it < TOK / 64; it += G) {
        const int cs = 0, c = (tid & 63) * 8;
        const f32x4 wa0 = *(const f32x4*)(conv_w + c), wa1 = *(const f32x4*)(conv_w + c + 4);
        const f32x4 wb0 = *(const f32x4*)(conv_w + 512 + c), wb1 = *(const f32x4*)(conv_w + 512 + c + 4);
        const f32x4 wc0 = *(const f32x4*)(conv_w + 1024 + c), wc1 = *(const f32x4*)(conv_w + 1024 + c + 4);
#pragma unroll 2
        for (int q = 0; q < 8; ++q) {
            const int t = it * 64 + (tid >> 6) + 8 * q;
            const int tin = t % SEQ;
            const bf16_t* pr = PROJ + (size_t)t * EVIN;
            const u32x4 bg = *(const u32x4*)(pr + c), c0 = *(const u32x4*)(pr + 512 + c), u0 = *(const u32x4*)(pr + 1024 + c);
            u32x4 c1 = {0u, 0u, 0u, 0u}, u1 = c1, c2 = c1, u2 = c1;
            if (tin >= 1) { c1 = *(const u32x4*)(pr - EVIN + 512 + c); u1 = *(const u32x4*)(pr - EVIN + 1024 + c); }
            if (tin >= 2) { c2 = *(const u32x4*)(pr - 2 * EVIN + 512 + c); u2 = *(const u32x4*)(pr - 2 * EVIN + 1024 + c); }
            u32x4 o;
#pragma unroll
            for (int e = 0; e < 4; ++e) {
                const float w0l = e < 2 ? wa0[2 * e] : wa1[2 * e - 4], w0h = e < 2 ? wa0[2 * e + 1] : wa1[2 * e - 3];
                const float w1l = e < 2 ? wb0[2 * e] : wb1[2 * e - 4], w1h = e < 2 ? wb0[2 * e + 1] : wb1[2 * e - 3];
                const float w2l = e < 2 ? wc0[2 * e] : wc1[2 * e - 4], w2h = e < 2 ? wc0[2 * e + 1] : wc1[2 * e - 3];
                const float yl = w0l * (bflo(c2[e]) * bflo(u2[e])) + w1l * (bflo(c1[e]) * bflo(u1[e])) + w2l * (bflo(c0[e]) * bflo(u0[e]));
                const float yh = w0h * (bfhi(c2[e]) * bfhi(u2[e])) + w1h * (bfhi(c1[e]) * bfhi(u1[e])) + w2h * (bfhi(c0[e]) * bfhi(u0[e]));
                o[e] = pk2(bflo(bg[e]) * yl, bfhi(bg[e]) * yh);
            }
            *(u32x4*)(MIX + (size_t)t * DM + cs + c) = o;
        }
    }
    LAS bf16_t* Kl = (LAS bf16_t*)lds; LAS bf16_t* Vl = Kl + 64 * LP;
    const int l31 = lane & 31, hi = lane >> 5;
    for (int ui = bid; ui < 1024; ui += G) {
        const int b = ui >> 8, n = (ui >> 2) & 63, h = ui & 3;
        const int j = tid >> 3, c8 = tid & 7;
        const bf16_t* rowp = PROJ + (size_t)(b * SEQ + 64 * n + j) * EVIN + h * 128 + 8 * c8;
        const u32x4 k1 = *(const u32x4*)(rowp + 2048), k2 = *(const u32x4*)(rowp + 2048 + 64);
        const u32x4 v1 = *(const u32x4*)(rowp + 2560), v2 = *(const u32x4*)(rowp + 2560 + 64);
        const float fac = 0.08838834764831845f * __builtin_amdgcn_exp2f((float)(63 - j) * LOG2G[h]);
        u32x4 o1, o2; rot8(k1, k2, rope + (size_t)(64 * n + j) * 64 + 8 * c8, fac, o1, o2);
        *(LAS u32x4*)(Kl + j * LP + 8 * c8) = o1; *(LAS u32x4*)(Kl + j * LP + 64 + 8 * c8) = o2;
        *(LAS u32x4*)(Vl + j * LP + 8 * c8) = v1; *(LAS u32x4*)(Vl + j * LP + 64 + 8 * c8) = v2;
        WG_BARRIER();
        const int eblk = (wave & 3) * 32, dbase = (wave >> 2) * 64;
        f32x16 a0 = {}, a1 = {};
#pragma unroll
        for (int ks = 0; ks < 4; ++ks) {
            bf16x8 A, B0, B1;
            GATHER8(A, Vl, (16 * ks + 8 * hi + jj), eblk + l31);
            GATHER8(B0, Kl, (16 * ks + 8 * hi + jj), dbase + l31);
            GATHER8(B1, Kl, (16 * ks + 8 * hi + jj), dbase + 32 + l31);
            a0 = MFMA32(A, B0, a0); a1 = MFMA32(A, B1, a1);
        }
        bf16_t* kvp = (bf16_t*)KV + (size_t)ui * 16384 + dbase + l31;
#pragma unroll
        for (int r = 0; r < 16; ++r) { const int e = eblk + crow(r, hi); kvp[e * 128] = (bf16_t)(pk2(a0[r], 0.f) & 0xffffu); kvp[e * 128 + 32] = (bf16_t)(pk2(a1[r], 0.f) & 0xffffu); }
        WG_BARRIER();
    }
}

__device__ __forceinline__ void scan_phase(const float* KV, bf16_t* ST, int bid, int G, int tid) {
    for (int p = bid * 512 + tid; p < 16 * 8192; p += G * 512) {
        const int bh = p >> 13, idx = (p & 8191) * 2, b = bh >> 2, h = bh & 3;
        const float dec = DEC64[h];
        float s0 = 0.f, s1 = 0.f;
#pragma unroll 8
        for (int n = 0; n < 64; ++n) {
            const size_t off = (size_t)((b * 64 + n) * 4 + h) * 16384 + idx;
            const unsigned kvw = *(const unsigned*)((const bf16_t*)KV + off); const f32x2 kv = {bflo(kvw), bfhi(kvw)};
            *(unsigned*)(ST + off) = pk2(s0, s1);
            s0 = s0 * dec + kv[0]; s1 = s1 * dec + kv[1];
        }
    }
}

__device__ __forceinline__ void evenB_phase(LAS unsigned char* lds, const bf16_t* PROJ, const f32x2* rope, const bf16_t* ST, bf16_t* MIX, const float* retg,
                                            int bid, int G, int tid, int wave, int lane) {
    LAS bf16_t* Ql = (LAS bf16_t*)lds; LAS bf16_t* Kl = Ql + 64 * LP; LAS bf16_t* Vl = Kl + 64 * LP; LAS float* red = (LAS float*)(Vl + 64 * LP);
    const int l31 = lane & 31, hi = lane >> 5;
    for (int ui = bid; ui < 1024; ui += G) {
        const int b = ui >> 8, n = (ui >> 2) & 63, h = ui & 3;
        const float lg = LOG2G[h];
        {
            const int j = tid >> 3, c8 = tid & 7;
            const bf16_t* rowp = PROJ + (size_t)(b * SEQ + 64 * n + j) * EVIN + h * 128 + 8 * c8;
            const u32x4 q1 = *(const u32x4*)(rowp + 1536), q2 = *(const u32x4*)(rowp + 1536 + 64);
            const u32x4 k1 = *(const u32x4*)(rowp + 2048), k2 = *(const u32x4*)(rowp + 2048 + 64);
            const u32x4 v1 = *(const u32x4*)(rowp + 2560), v2 = *(const u32x4*)(rowp + 2560 + 64);
            const f32x2* rp = rope + (size_t)(64 * n + j) * 64 + 8 * c8;
            u32x4 o1, o2;
            rot8(q1, q2, rp, 1.0f, o1, o2);
            *(LAS u32x4*)(Ql + j * LP + 8 * c8) = o1; *(LAS u32x4*)(Ql + j * LP + 64 + 8 * c8) = o2;
            rot8(k1, k2, rp, 0.08838834764831845f, o1, o2);
            *(LAS u32x4*)(Kl + j * LP + 8 * c8) = o1; *(LAS u32x4*)(Kl + j * LP + 64 + 8 * c8) = o2;
            *(LAS u32x4*)(Vl + j * LP + 8 * c8) = v1; *(LAS u32x4*)(Vl + j * LP + 64 + 8 * c8) = v2;
        }
        WG_BARRIER();
        const int eblk = (wave & 3) * 32, iblk = (wave >> 2) * 32;
        f32x16 p0 = {}, p1 = {};
#pragma unroll
        for (int ks = 0; ks < 8; ++ks) {
            const bf16x8 kA0 = *(const LAS bf16x8*)(Kl + l31 * LP + 16 * ks + 8 * hi), kA1 = *(const LAS bf16x8*)(Kl + (32 + l31) * LP + 16 * ks + 8 * hi);
            const bf16x8 qB = *(const LAS bf16x8*)(Ql + (iblk + l31) * LP + 16 * ks + 8 * hi);
            p0 = MFMA32(kA0, qB, p0); p1 = MFMA32(kA1, qB, p1);
        }
        const int i = iblk + l31;
#pragma unroll
        for (int r = 0; r < 16; ++r) {
            const int j0 = crow(r, hi);
            const int d0 = i - j0, d1 = i - 32 - j0;
            p0[r] *= __builtin_amdgcn_exp2f((float)(d0 < 0 ? -d0 : d0) * lg);
            p1[r] *= __builtin_amdgcn_exp2f((float)(d1 < 0 ? -d1 : d1) * lg);
        }
        bf16x8 pk[4];
        pk[0] = __builtin_bit_cast(bf16x8, (u32x4){pk2(p0[0], p0[1]), pk2(p0[2], p0[3]), pk2(p0[4], p0[5]), pk2(p0[6], p0[7])});
        pk[1] = __builtin_bit_cast(bf16x8, (u32x4){pk2(p0[8], p0[9]), pk2(p0[10], p0[11]), pk2(p0[12], p0[13]), pk2(p0[14], p0[15])});
        pk[2] = __builtin_bit_cast(bf16x8, (u32x4){pk2(p1[0], p1[1]), pk2(p1[2], p1[3]), pk2(p1[4], p1[5]), pk2(p1[6], p1[7])});
        pk[3] = __builtin_bit_cast(bf16x8, (u32x4){pk2(p1[8], p1[9]), pk2(p1[10], p1[11]), pk2(p1[12], p1[13]), pk2(p1[14], p1[15])});
        f32x16 oi = {}, ox = {};
#pragma unroll
        for (int m = 0; m < 4; ++m) {
            bf16x8 A;
            GATHER8(A, Vl, (16 * m + (jj & 3) + 8 * (jj >> 2) + 4 * hi), eblk + l31);
            oi = MFMA32(A, pk[m], oi);
        }
        const bf16_t* stp = ST + (size_t)ui * 16384 + (size_t)(eblk + l31) * 128 + 8 * hi;
#pragma unroll
        for (int ks = 0; ks < 8; ++ks) {
            const bf16x8 A = *(const bf16x8*)(stp + 16 * ks);
            const bf16x8 qB = *(const LAS bf16x8*)(Ql + (iblk + l31) * LP + 16 * ks + 8 * hi);
            ox = MFMA32(A, qB, ox);
        }
        const float qd = __builtin_amdgcn_exp2f((float)(i + 1) * lg);
        float ss = 0.f;
#pragma unroll
        for (int r = 0; r < 16; ++r) { oi[r] += qd * ox[r]; ss += oi[r] * oi[r]; }
        ss += __shfl_xor(ss, 32);
        if (hi == 0) red[wave * 32 + l31] = ss;
        WG_BARRIER();
        const int wb = (wave >> 2) * 4;
        const float tot = (red[wb * 32 + l31] + red[(wb + 1) * 32 + l31]) + (red[(wb + 2) * 32 + l31] + red[(wb + 3) * 32 + l31]);
        const float rstd = __builtin_amdgcn_rsqf(tot * (1.0f / 128.0f) + EPS);
        const size_t t = (size_t)(b * SEQ + 64 * n + i);
#pragma unroll
        for (int g4 = 0; g4 < 4; ++g4) {
            const int e = eblk + 8 * g4 + 4 * hi;
            const u32x2 gw = *(const u32x2*)(PROJ + t * EVIN + 3072 + h * 128 + e);
            const f32x4 gn = *(const f32x4*)(retg + h * 128 + e);
            const float g0 = bflo(gw[0]), g1 = bfhi(gw[0]), g2 = bflo(gw[1]), g3 = bfhi(gw[1]);
            const float y0 = oi[4 * g4] * rstd * gn[0] * pg8::silu_f(g0), y1 = oi[4 * g4 + 1] * rstd * gn[1] * pg8::silu_f(g1);
            const float y2 = oi[4 * g4 + 2] * rstd * gn[2] * pg8::silu_f(g2), y3 = oi[4 * g4 + 3] * rstd * gn[3] * pg8::silu_f(g3);
            *(u32x2*)(MIX + t * DM + 512 + h * 128 + e) = (u32x2){pk2(y0, y1), pk2(y2, y3)};
        }
        WG_BARRIER();
    }
}

constexpr int VP = 72;
#define LDS_BARRIER() do { asm volatile("s_waitcnt lgkmcnt(0)" ::: "memory"); __builtin_amdgcn_s_barrier(); asm volatile("" ::: "memory"); } while (0)
__device__ __forceinline__ void attn_phase(LAS unsigned char* lds, const bf16_t* QK, const bf16_t* VT, bf16_t* MIX, const float* gq, const float* gk, int bid, int G, int tid, int wave, int lane) {
    LAS bf16_t* Kl = (LAS bf16_t*)lds; LAS bf16_t* Vtl = Kl + 64 * LP; LAS unsigned* flag = (LAS unsigned*)(Vtl + 128 * VP);
    const int l31 = lane & 31, hi = lane >> 5;
    const float qscale = 0.08838834764831845f * 1.4426950408889634f;
    const int krow = tid >> 4, kseg = tid & 15, vrow = tid >> 3, vseg = tid & 7;
    const int vcu = (G % 8 == 0) ? (bid % 8) * (G / 8) + bid / 8 : bid;
    for (int ui = vcu; ui < 512; ui += G) {
        const int qb = ui & 15, bh = ui >> 4, b = bh >> 3, h = bh & 7;
        const int q0 = qb * 256, rowbase = b * SEQ;
        const int qrow = q0 + 32 * wave + l31, qmax_w = q0 + 32 * wave + 31;
        const int jmax = 4 * qb + 3;
        const bf16_t* kgp = QK + (size_t)(rowbase + krow) * 2048 + 1024 + h * 128 + 8 * kseg;
        const bf16_t* vgp = VT + (size_t)(h * 128 + vrow) * TOK + rowbase + 8 * vseg;
        bf16x8 qf[8];
        {
            u32x4 qraw[8]; float ss = 0.f;
#pragma unroll
            for (int d0 = 0; d0 < 8; ++d0) { qraw[d0] = *(const u32x4*)(QK + (size_t)(rowbase + qrow) * 2048 + h * 128 + 16 * d0 + 8 * hi);
#pragma unroll
                for (int i = 0; i < 4; ++i) { const float a0 = bflo(qraw[d0][i]), a1 = bfhi(qraw[d0][i]); ss += a0 * a0 + a1 * a1; } }
            ss += __shfl_xor(ss, 32);
            const float rq = __builtin_amdgcn_rsqf(ss * (1.0f / 128.0f) + EPS) * qscale;
#pragma unroll
            for (int d0 = 0; d0 < 8; ++d0) {
                const f32x4 g0 = *(const f32x4*)(gq + 16 * d0 + 8 * hi), g1 = *(const f32x4*)(gq + 16 * d0 + 8 * hi + 4);
                u32x4 w;
                w[0] = pk2(bflo(qraw[d0][0]) * rq * g0[0], bfhi(qraw[d0][0]) * rq * g0[1]); w[1] = pk2(bflo(qraw[d0][1]) * rq * g0[2], bfhi(qraw[d0][1]) * rq * g0[3]);
                w[2] = pk2(bflo(qraw[d0][2]) * rq * g1[0], bfhi(qraw[d0][2]) * rq * g1[1]); w[3] = pk2(bflo(qraw[d0][3]) * rq * g1[2], bfhi(qraw[d0][3]) * rq * g1[3]);
                qf[d0] = __builtin_bit_cast(bf16x8, w);
            }
        }
        asm volatile("" ::: "memory");
        u32x4 kreg0 = *(const u32x4*)(kgp + (size_t)(64 * jmax) * 2048), kreg1 = *(const u32x4*)(kgp + (size_t)(64 * jmax + 32) * 2048);
        u32x4 vreg0 = *(const u32x4*)(vgp + 64 * jmax), vreg1 = *(const u32x4*)(vgp + (size_t)64 * TOK + 64 * jmax);
        f32x16 o[4];
#pragma unroll
        for (int d = 0; d < 4; ++d) o[d] = (f32x16){};
        float carry = 0.f; bool wdone = false;
        if (lane == 0) flag[wave] = 0u;
        for (int j = jmax; j >= 0; --j) {
            LDS_BARRIER();
            if (j != jmax) { unsigned all = 1u;
#pragma unroll
                for (int w = 0; w < 8; ++w) all &= flag[w];
                if (all) break; }
            const f32x4 gk0 = *(const f32x4*)(gk + 8 * kseg), gk1 = *(const f32x4*)(gk + 8 * kseg + 4);
#pragma unroll
            for (int i = 0; i < 2; ++i) {
                const u32x4 kr = i ? kreg1 : kreg0;
                float kf[8]; float ss = 0.f;
#pragma unroll
                for (int e = 0; e < 4; ++e) { kf[2 * e] = bflo(kr[e]); kf[2 * e + 1] = bfhi(kr[e]); ss += kf[2 * e] * kf[2 * e] + kf[2 * e + 1] * kf[2 * e + 1]; }
                ss += __shfl_xor(ss, 1); ss += __shfl_xor(ss, 2); ss += __shfl_xor(ss, 4); ss += __shfl_xor(ss, 8);
                const float rk = __builtin_amdgcn_rsqf(ss * (1.0f / 128.0f) + EPS);
                u32x4 w; w[0] = pk2(kf[0] * rk * gk0[0], kf[1] * rk * gk0[1]); w[1] = pk2(kf[2] * rk * gk0[2], kf[3] * rk * gk0[3]);
                w[2] = pk2(kf[4] * rk * gk1[0], kf[5] * rk * gk1[1]); w[3] = pk2(kf[6] * rk * gk1[2], kf[7] * rk * gk1[3]);
                *(LAS u32x4*)(Kl + (krow + 32 * i) * LP + 8 * kseg) = w;
                *(LAS u32x4*)(Vtl + (vrow + 64 * i) * VP + 8 * vseg) = i ? vreg1 : vreg0;
            }
            if (j > 0) {
                kreg0 = *(const u32x4*)(kgp + (size_t)(64 * (j - 1)) * 2048); kreg1 = *(const u32x4*)(kgp + (size_t)(64 * (j - 1) + 32) * 2048);
                vreg0 = *(const u32x4*)(vgp + 64 * (j - 1)); vreg1 = *(const u32x4*)(vgp + (size_t)64 * TOK + 64 * (j - 1));
            }
            LDS_BARRIER();
            if (!wdone && 64 * j <= qmax_w) {
                f32x16 p0 = {}, p1 = {};
#pragma unroll
                for (int d0 = 0; d0 < 8; ++d0) {
                    const bf16x8 kA0 = *(const LAS bf16x8*)(Kl + l31 * LP + 16 * d0 + 8 * hi), kA1 = *(const LAS bf16x8*)(Kl + (32 + l31) * LP + 16 * d0 + 8 * hi);
                    p0 = MFMA32(kA0, qf[d0], p0); p1 = MFMA32(kA1, qf[d0], p1);
                    if (d0 & 1) __builtin_amdgcn_sched_barrier(0);
                }
                const int keyb = 64 * j + 4 * hi;
                float run = carry;
#pragma unroll
                for (int pp = 1; pp >= 0; --pp) {
#pragma unroll
                    for (int g = 3; g >= 0; --g) {
                        float lk[4], lb[4];
#pragma unroll
                        for (int i = 0; i < 4; ++i) {
                            const float z = pp ? p1[4 * g + i] : p0[4 * g + i];
                            const bool valid = (keyb + 32 * pp + 8 * g + i) < qrow;
                            const float sp = fmaxf(z, 0.f) + __builtin_amdgcn_logf(1.0f + __builtin_amdgcn_exp2f(-fabsf(z)));
                            lk[i] = valid ? -sp : 0.f; lb[i] = valid ? (z - sp) : -__builtin_inff();
                        }
                        const float gs = (lk[0] + lk[1]) + (lk[2] + lk[3]);
                        const float pgs = __shfl_xor(gs, 32);
                        const float off = run + (hi == 0 ? pgs : 0.f);
                        const float A3 = off, A2 = off + lk[3], A1 = A2 + lk[2], A0 = A1 + lk[1];
                        const float w0 = __builtin_amdgcn_exp2f(lb[0] + A0), w1 = __builtin_amdgcn_exp2f(lb[1] + A1), w2 = __builtin_amdgcn_exp2f(lb[2] + A2), w3 = __builtin_amdgcn_exp2f(lb[3] + A3);
                        if (pp) { p1[4 * g] = w0; p1[4 * g + 1] = w1; p1[4 * g + 2] = w2; p1[4 * g + 3] = w3; }
                        else    { p0[4 * g] = w0; p0[4 * g + 1] = w1; p0[4 * g + 2] = w2; p0[4 * g + 3] = w3; }
                        run += gs + pgs;
                    }
                }
                carry = run;
                bf16x8 pk[4];
                pk[0] = __builtin_bit_cast(bf16x8, (u32x4){pk2(p0[0], p0[1]), pk2(p0[2], p0[3]), pk2(p0[4], p0[5]), pk2(p0[6], p0[7])});
                pk[1] = __builtin_bit_cast(bf16x8, (u32x4){pk2(p0[8], p0[9]), pk2(p0[10], p0[11]), pk2(p0[12], p0[13]), pk2(p0[14], p0[15])});
                pk[2] = __builtin_bit_cast(bf16x8, (u32x4){pk2(p1[0], p1[1]), pk2(p1[2], p1[3]), pk2(p1[4], p1[5]), pk2(p1[6], p1[7])});
                pk[3] = __builtin_bit_cast(bf16x8, (u32x4){pk2(p1[8], p1[9]), pk2(p1[10], p1[11]), pk2(p1[12], p1[13]), pk2(p1[14], p1[15])});
#pragma unroll
                for (int db = 0; db < 4; ++db)
#pragma unroll
                    for (int m = 0; m < 4; ++m) {
                        const LAS bf16_t* vp = Vtl + (32 * db + l31) * VP + 16 * m + 4 * hi;
                        const u32x2 lo = *(const LAS u32x2*)vp, hi2 = *(const LAS u32x2*)(vp + 8);
                        const bf16x8 vA = __builtin_bit_cast(bf16x8, (u32x4){lo[0], lo[1], hi2[0], hi2[1]});
                        o[db] = MFMA32(vA, pk[m], o[db]);
                        if (m == 3) __builtin_amdgcn_sched_barrier(0);
                    }
                wdone = __all(carry < -64.0f) != 0;
                if (lane == 0) flag[wave] = wdone ? 1u : 0u;
            }
        }
        bf16_t* op = MIX + (size_t)(rowbase + qrow) * DM + h * 128 + 4 * hi;
#pragma unroll
        for (int db = 0; db < 4; ++db)
#pragma unroll
            for (int g4 = 0; g4 < 4; ++g4)
                *(u32x2*)(op + 32 * db + 8 * g4) = (u32x2){pk2(o[db][4 * g4], o[db][4 * g4 + 1]), pk2(o[db][4 * g4 + 2], o[db][4 * g4 + 3])};
        WG_BARRIER();
    }
}

#define XB_TMO      128
#define XB_XCNT(j)  (256  + 64 * (j))
#define XB_XSUB(j)  (1280 + 64 * (j))
#define XB_XGEN(j)  (2304 + 64 * (j))
#define XB_TOP      3328
#define XB_TOPGEN   3392
#define XCD_BAR_WORDS 3456
#define XB_SPIN_CAP (1u << 18)

__device__ __forceinline__ unsigned xb_ld(unsigned* p)              { return __hip_atomic_load(p, __ATOMIC_RELAXED, __HIP_MEMORY_SCOPE_AGENT); }
__device__ __forceinline__ unsigned xb_add(unsigned* p, unsigned v) { return __hip_atomic_fetch_add(p, v, __ATOMIC_RELAXED, __HIP_MEMORY_SCOPE_AGENT); }
__device__ __forceinline__ unsigned xb_xcc_id() { return (unsigned)__builtin_amdgcn_s_getreg((3 << 11) | 20) & 0xFu; }
#define XB_SPIN(cond, bar) do { unsigned _sp = 0; while (cond) { __builtin_amdgcn_s_sleep(1); \
    if ((++_sp & 255u) == 0u) { if (xb_ld(&(bar)[XB_TMO])) break; if (_sp > XB_SPIN_CAP) { atomicAdd(&(bar)[XB_TMO], 1u); break; } } } } while (0)

struct XcdBarrier {
    unsigned* bar; unsigned x;
    volatile LAS unsigned* st;
};

__device__ __forceinline__ XcdBarrier xcd_barrier_post(unsigned* bar, volatile LAS unsigned* st, bool is_t0) {
    XcdBarrier b; b.bar = bar; b.x = xb_xcc_id(); b.st = st;
    if (is_t0) (void)xb_add(&bar[XB_XCNT(b.x)], 1u);
    return b;
}
__device__ __forceinline__ void xcd_barrier_complete(unsigned* bar, unsigned x, unsigned& nloc, unsigned& nx) {
    const unsigned G = gridDim.x * gridDim.y * gridDim.z;
    unsigned sum, cnt, mine, sp = 0u;
    for (;;) {
        sum = 0u; cnt = 0u; mine = 0u;
#pragma unroll
        for (unsigned j = 0; j < 16; ++j) { const unsigned c = xb_ld(&bar[XB_XCNT(j)]); sum += c; cnt += (c > 0u) ? 1u : 0u; mine = (j == x) ? c : mine; }
        if (sum == G) break;
        __builtin_amdgcn_s_sleep(1);
        if ((++sp & 255u) == 0u) { if (xb_ld(&bar[XB_TMO])) break; if (sp > XB_SPIN_CAP) { atomicAdd(&bar[XB_TMO], 1u); break; } }
    }
    nloc = mine > 0u ? mine : 1u; nx = cnt > 0u ? cnt : 1u;
}

__device__ __forceinline__ void xcd_barrier(const XcdBarrier& b, bool is_t0) {
    asm volatile("s_waitcnt vmcnt(0)" ::: "memory");
    __syncthreads();
    if (is_t0) {
        unsigned* bar = b.bar;
        __builtin_amdgcn_s_waitcnt(0);
        unsigned nloc = b.st[0], nx = b.st[1];
        if (nloc == 0u) { xcd_barrier_complete(bar, b.x, nloc, nx); b.st[0] = nloc; b.st[1] = nx; }
        const unsigned old = xb_add(&bar[XB_XSUB(b.x)], 1u);
        const unsigned gen = old / nloc;
        if (old + 1u == (gen + 1u) * nloc) {
            __builtin_amdgcn_fence(__ATOMIC_RELEASE, "agent");
            asm volatile("s_waitcnt vmcnt(0)" ::: "memory");
            const unsigned og = xb_add(&bar[XB_TOP], 1u);
            const unsigned tg = og / nx;
            if (og + 1u == (tg + 1u) * nx) xb_add(&bar[XB_TOPGEN], 1u);
            else XB_SPIN(xb_ld(&bar[XB_TOPGEN]) == tg, bar);
            __builtin_amdgcn_fence(__ATOMIC_ACQUIRE, "agent");
            xb_add(&bar[XB_XGEN(b.x)], 1u);
            asm volatile("s_waitcnt vmcnt(0)" ::: "memory");
        } else {
            XB_SPIN(xb_ld(&bar[XB_XGEN(b.x)]) == gen, bar);
            __builtin_amdgcn_fence(__ATOMIC_ACQUIRE, "agent");
            asm volatile("s_waitcnt vmcnt(0)" ::: "memory");
        }
    }
    __syncthreads();
}

constexpr size_t WS_BAR = 4096;
struct Args { const float* in[17]; float* out; unsigned char* ws; };
enum Phase { PH_PROLOGUE = 0, PH_P1, PH_GEMM_EVIN, PH_EVENA, PH_SCAN, PH_EVENB, PH_GEMM_QK, PH_GEMM_VT, PH_ATTN, PH_GEMM_OUT, PH_GEMM_GU, PH_GEMM_DN };

typedef const Args __attribute__((address_space(4)))* KArgs;
__device__ __forceinline__ int hw_lane() { int l; asm volatile("v_mbcnt_lo_u32_b32 %0, -1, 0\n\tv_mbcnt_hi_u32_b32 %0, -1, %0" : "=v"(l)); return l; }
template <int PH> __device__ __forceinline__ void run_phase(int l, LAS unsigned char* lds, int wave_s) {
    KArgs ap = (KArgs)__builtin_amdgcn_kernarg_segment_ptr();
    asm volatile("" : "+s"(ap));
    Args a;
#pragma unroll
    for (int i = 0; i < 17; ++i) a.in[i] = ap->in[i];
    a.out = ap->out; a.ws = ap->ws;
    int tid_ = wave_s * 64 + hw_lane(); asm volatile("" : "+v"(tid_));
    const int tid = tid_, lane = tid & 63, wave = __builtin_amdgcn_readfirstlane(tid >> 6);
    int bid_ = blockIdx.x; asm volatile("" : "+s"(bid_));
    const int bid = bid_, G = gridDim.x;
    unsigned char* ws = a.ws;
    float* out = a.out;
    const int jl = l >> 1;
    const float* modl = (const float*)(ws + WS_MOD) + (size_t)l * 4 * 6144;
    const f32x2* rope = (const f32x2*)(ws + WS_ROPE);
    bf16_t* XN = (bf16_t*)(ws + WS_XN); bf16_t* PROJ = (bf16_t*)(ws + WS_PROJ); bf16_t* MIX = (bf16_t*)(ws + WS_MIX);
    float* KV = (float*)(ws + WS_KV); bf16_t* ST = (bf16_t*)(ws + WS_XN);
    float* ssq = (float*)(ws + WS_SSQ);
    const float* shw = (const float*)(ws + WS_SHW) + (size_t)l * 3 * 4 * LDSHW;
    const float* xin = (l == 0) ? a.in[0] : out;
    if constexpr (PH == PH_PROLOGUE || PH == PH_P1) {
        Ptrs p;
        p.x = a.in[0]; p.c = a.in[1]; p.ada_w = a.in[2]; p.ada_b = a.in[3]; p.norm_mix_g = a.in[4]; p.norm_ffn_g = a.in[5]; p.ev_w_in = a.in[6]; p.ev_conv_w = a.in[7];
        p.ev_ret_norm_g = a.in[8]; p.ev_w_out = a.in[9]; p.od_w_qkv = a.in[10]; p.od_q_norm_g = a.in[11]; p.od_k_norm_g = a.in[12]; p.od_w_out = a.in[13];
        p.ffn_w_gate = a.in[14]; p.ffn_w_up = a.in[15]; p.ffn_w_down = a.in[16];
        if constexpr (PH == PH_PROLOGUE) prologue(p, ws, lds, bid, G, tid, wave, lane);
        else if (G > 36) {
            if (bid < 36) shw_items(p, ws, lds, 0, 1, bid, 36, tid, wave, lane); else norm0_rows(p.x, XN, p.norm_mix_g, (const float*)(ws + WS_MOD), ssq, bid - 36, G - 36, wave, lane);
        } else { norm0_rows(p.x, XN, p.norm_mix_g, (const float*)(ws + WS_MOD), ssq, bid, G, wave, lane); shw_items(p, ws, lds, 0, NL, bid, G, tid, wave, lane); }
    } else if constexpr (PH == PH_GEMM_EVIN) {
        pg8::Gemm g{XN, (const bf16_t*)(ws + W_EVIN) + (size_t)jl * EVIN * DM, TOK, EVIN, DM}; pg8::StaticOrder S; S.init(TOK, EVIN, G, bid);
        pg8::EpiScaleBias E{PROJ, EVIN, ssq + (size_t)(2 * l) * TOK, shw, LDSHW};
        pg8::gemm_phase<pg8::EpiScaleBias, pg8::StaticOrder, true, true>(lds, g, S, E, tid);
        if (G == 256 && bid >= 128) {
            Ptrs p;
            p.x = a.in[0]; p.c = a.in[1]; p.ada_w = a.in[2]; p.ada_b = a.in[3]; p.norm_mix_g = a.in[4]; p.norm_ffn_g = a.in[5]; p.ev_w_in = a.in[6]; p.ev_conv_w = a.in[7];
            p.ev_ret_norm_g = a.in[8]; p.ev_w_out = a.in[9]; p.od_w_qkv = a.in[10]; p.od_q_norm_g = a.in[11]; p.od_k_norm_g = a.in[12]; p.od_w_out = a.in[13];
            p.ffn_w_gate = a.in[14]; p.ffn_w_up = a.in[15]; p.ffn_w_down = a.in[16];
            if (l == 0) shw_items(p, ws, lds, 1, 3, bid - 128, 128, tid, wave, lane); else shw_items(p, ws, lds, 3, 4, bid - 128, 128, tid, wave, lane);
        }
    } else if constexpr (PH == PH_EVENA) {
        evenA_phase(lds, PROJ, rope, KV, MIX, a.in[7] + (size_t)jl * 3 * 512, bid, G, tid, wave, lane);
    } else if constexpr (PH == PH_SCAN) {
        scan_phase(KV, ST, bid, G, tid);
    } else if constexpr (PH == PH_EVENB) {
        evenB_phase(lds, PROJ, rope, ST, MIX, a.in[8] + jl * 512, bid, G, tid, wave, lane);
    } else if constexpr (PH == PH_GEMM_QK) {
        const bf16_t* wqkv_t = (const bf16_t*)(ws + W_ODQKV) + (size_t)jl * 3 * DM * DM;
        pg8::Gemm g{XN, wqkv_t, TOK, 2048, DM}; pg8::StaticOrder S; S.init(TOK, 2048, G, bid);
        pg8::EpiScaleBias E{PROJ, 2048, ssq + (size_t)(2 * l) * TOK, shw, LDSHW};
        pg8::gemm_phase<pg8::EpiScaleBias, pg8::StaticOrder, true, true>(lds, g, S, E, tid);
    } else if constexpr (PH == PH_GEMM_VT) {
        const bf16_t* wqkv_t = (const bf16_t*)(ws + W_ODQKV) + (size_t)jl * 3 * DM * DM;
        bf16_t* VT = PROJ + (size_t)TOK * 2048;
        pg8::Gemm g{wqkv_t + (size_t)2048 * DM, XN, DM, TOK, DM}; pg8::StaticOrder S; S.init(DM, TOK, G, bid);
        pg8::EpiScaleBiasT E{VT, TOK, ssq + (size_t)(2 * l) * TOK, shw + 2048, LDSHW};
        pg8::gemm_phase<pg8::EpiScaleBiasT, pg8::StaticOrder, true, true>(lds, g, S, E, tid);
    } else if constexpr (PH == PH_ATTN) {
        attn_phase(lds, PROJ, PROJ + (size_t)TOK * 2048, MIX, a.in[11] + jl * 128, a.in[12] + jl * 128, bid, G, tid, wave, lane);
    } else if constexpr (PH == PH_GEMM_OUT) {
        const bf16_t* wout_t = (l & 1) ? (const bf16_t*)(ws + W_ODOUT) + (size_t)jl * DM * DM : (const bf16_t*)(ws + W_EVOUT) + (size_t)jl * DM * DM;
        pg8::Gemm g{MIX, wout_t, TOK, DM, DM}; pg8::StaticOrder S; S.init(TOK, DM, G, bid);
        pg8::EpiResidNext E{xin, out, modl + 2 * 1024, XN, a.in[5] + l * DM, modl + 4 * 1024, ssq + (size_t)(2 * l + 1) * TOK, 1};
        pg8::gemm_phase<pg8::EpiResidNext, pg8::StaticOrder, true, true>(lds, g, S, E, tid);
    } else if constexpr (PH == PH_GEMM_GU) {
        pg8::Gemm g{XN, (const bf16_t*)(ws + W_GU) + (size_t)l * 2 * DFF * DM, TOK, 2 * DFF, DM}; pg8::StaticOrder S; S.init(TOK, 2 * DFF, G, bid);
        pg8::EpiSwiGLU E{PROJ, DFF, ssq + (size_t)(2 * l + 1) * TOK, shw + (size_t)4 * LDSHW, shw + (size_t)8 * LDSHW, LDSHW};
        pg8::gemm_phase<pg8::EpiSwiGLU, pg8::StaticOrder, true, true>(lds, g, S, E, tid);
        if (l + 1 < NL && G == 256 && bid >= 128) {
            Ptrs p;
            p.x = a.in[0]; p.c = a.in[1]; p.ada_w = a.in[2]; p.ada_b = a.in[3]; p.norm_mix_g = a.in[4]; p.norm_ffn_g = a.in[5]; p.ev_w_in = a.in[6]; p.ev_conv_w = a.in[7];
            p.ev_ret_norm_g = a.in[8]; p.ev_w_out = a.in[9]; p.od_w_qkv = a.in[10]; p.od_q_norm_g = a.in[11]; p.od_k_norm_g = a.in[12]; p.od_w_out = a.in[13];
            p.ffn_w_gate = a.in[14]; p.ffn_w_up = a.in[15]; p.ffn_w_down = a.in[16];
            convert_layer(p, ws, lds, l + 1, (bid - 128) * 8 + wave, 128 * 8, wave, lane);
        }
    } else if constexpr (PH == PH_GEMM_DN) {
        const int nxt = (l + 1 < NL) ? 1 : 0, ln = nxt ? l + 1 : l;
        pg8::Gemm g{PROJ, (const bf16_t*)(ws + W_DN) + (size_t)l * DM * DFF, TOK, DM, DFF}; pg8::StaticOrder S; S.init(TOK, DM, G, bid);
        pg8::EpiResidNext E{out, out, modl + 5 * 1024, XN, a.in[4] + ln * DM, (const float*)(ws + WS_MOD) + (size_t)ln * 4 * 6144 + 1024, ssq + (size_t)(2 * ln) * TOK, nxt};
        pg8::gemm_phase<pg8::EpiResidNext, pg8::StaticOrder, true, true>(lds, g, S, E, tid);
    }
}

__device__ __forceinline__ void seam(LAS unsigned char* lds, int wave_s) {
    KArgs ap = (KArgs)__builtin_amdgcn_kernarg_segment_ptr();
    asm volatile("" : "+s"(ap));
    XcdBarrier b; b.bar = (unsigned*)(ap->ws + WS_BAR); b.x = xb_xcc_id(); b.st = (volatile LAS unsigned*)(lds + LDS_EXTRA);
    xcd_barrier(b, wave_s == 0 && hw_lane() == 0);
}

__global__ void __launch_bounds__(512, 2) mk_fwd(Args a_unused) {
    extern __shared__ __attribute__((aligned(16))) unsigned char lds_raw[];
    cg::grid_group grid = cg::this_grid();
    LAS unsigned char* lds = (LAS unsigned char*)lds_raw;
    const int wave_s = __builtin_amdgcn_readfirstlane((int)threadIdx.x >> 6);
    if (wave_s == 0 && hw_lane() < 4) ((volatile LAS unsigned*)(lds + LDS_EXTRA))[hw_lane()] = 0u;
    if (blockIdx.x == 0) { KArgs a = (KArgs)__builtin_amdgcn_kernarg_segment_ptr(); unsigned* bw = (unsigned*)(a->ws + WS_BAR); for (int i = wave_s * 64 + hw_lane(); i < XCD_BAR_WORDS; i += 512) bw[i] = 0u; }
    run_phase<PH_PROLOGUE>(0, lds, wave_s);
    grid.sync();
    { KArgs ap = (KArgs)__builtin_amdgcn_kernarg_segment_ptr(); asm volatile("" : "+s"(ap)); (void)xcd_barrier_post((unsigned*)(ap->ws + WS_BAR), (volatile LAS unsigned*)(lds + LDS_EXTRA), wave_s == 0 && hw_lane() == 0); }
    run_phase<PH_P1>(0, lds, wave_s);
    seam(lds, wave_s);
#pragma unroll 1
    for (int l = 0; l < NL; ++l) {
        if ((l & 1) == 0) {
            run_phase<PH_GEMM_EVIN>(l, lds, wave_s);
            seam(lds, wave_s);
            run_phase<PH_EVENA>(l, lds, wave_s);
            seam(lds, wave_s);
            run_phase<PH_SCAN>(l, lds, wave_s);
            seam(lds, wave_s);
            run_phase<PH_EVENB>(l, lds, wave_s);
        } else {
            run_phase<PH_GEMM_QK>(l, lds, wave_s);
            run_phase<PH_GEMM_VT>(l, lds, wave_s);
            seam(lds, wave_s);
            run_phase<PH_ATTN>(l, lds, wave_s);
        }
        seam(lds, wave_s);
        run_phase<PH_GEMM_OUT>(l, lds, wave_s);
        seam(lds, wave_s);
        run_phase<PH_GEMM_GU>(l, lds, wave_s);
        seam(lds, wave_s);
        run_phase<PH_GEMM_DN>(l, lds, wave_s);
        if (l + 1 < NL) seam(lds, wave_s);
    }
}
}

extern "C" void kernel_launch(void* const* d_in, const int* in_sizes, int n_in, void* d_out, int out_size, void* d_ws, size_t ws_size, hipStream_t stream) {
    static int grid = 0;
    if (grid == 0) {
        if (n_in != 17 || out_size != mk::TOK * mk::DM || ws_size < mk::WS_END) { fprintf(stderr, "kernel_launch: unexpected shapes (n_in %d, out %d, ws %zu)\n", n_in, out_size, ws_size); grid = -1; return; }
        int dev = 0, cus = 0, per_cu = 0;
        (void)hipGetDevice(&dev); (void)hipDeviceGetAttribute(&cus, hipDeviceAttributeMultiprocessorCount, dev);
        if (hipFuncSetAttribute((const void*)mk::mk_fwd, hipFuncAttributeMaxDynamicSharedMemorySize, mk::LDS_BYTES) != hipSuccess) { fprintf(stderr, "kernel_launch: hipFuncSetAttribute failed\n"); grid = -1; return; }
        if (hipOccupancyMaxActiveBlocksPerMultiprocessor(&per_cu, (const void*)mk::mk_fwd, 512, mk::LDS_BYTES) != hipSuccess || per_cu < 1) fprintf(stderr, "kernel_launch: occupancy query says %d\n", per_cu);
        (void)hipGetLastError();
        grid = 256;
        if (cus != 256) fprintf(stderr, "kernel_launch: %d CUs reported, launching 256 workgroups\n", cus);
    }
    if (grid < 0) return;
    mk::Args a{};
    for (int i = 0; i < 17; ++i) a.in[i] = (const float*)d_in[i];
    a.out = (float*)d_out; a.ws = (unsigned char*)d_ws;
    void* args[] = {&a};
    hipError_t e = hipLaunchCooperativeKernel((const void*)mk::mk_fwd, dim3(grid), dim3(512), args, mk::LDS_BYTES, stream);
    if (e != hipSuccess) fprintf(stderr, "cooperative launch failed: %s (grid %d)\n", hipGetErrorString(e), grid);
}
```

```cpp
#include <hip/hip_runtime.h>
#include <hip/hip_cooperative_groups.h>
#include <cstdio>
#include <cstdint>
namespace cg = cooperative_groups;
namespace pg8 {
#define PG8_LAS __attribute__((address_space(3)))
typedef unsigned short bf16_t;
typedef short bf16x8 __attribute__((ext_vector_type(8)));
typedef float f32x4 __attribute__((ext_vector_type(4)));
typedef unsigned u32x4 __attribute__((ext_vector_type(4)));
constexpr int BM = 256, BK = 64, HALF = 128, HTB = HALF * BK * 2  , STAGE_BYTES = 8 * HTB, NXCD = 8, WGM = 6;

__host__ __device__ __forceinline__ int lds_byte(int r, int c) { const int st = (r >> 4) * 2 + (c >> 5), rr = r & 15, cc = c & 31, ob = rr * 64 + cc * 2; return st * 1024 + (ob ^ (((ob >> 9) & 1) << 5)); }
__host__ __device__ __forceinline__ void stage_rc(int b, int& R, int& C) { const int st = b / 1024, sb = b % 1024, swz = sb ^ (((sb >> 9) & 1) << 5); R = (st >> 1) * 16 + swz / 64; C = (st & 1) * 32 + (swz % 64) / 2; }
__host__ __device__ __forceinline__ int perm32(int rho) { const int n = rho >> 4, i = rho & 15; return 8 * (i >> 2) + 4 * n + (i & 3); }

struct Unit { int pm, pn; };
struct Gemm { const bf16_t* A; const bf16_t* Bt; int M, N, K; };

struct StaticOrder {
    int nM, nN, nwg, G, c;
    __host__ __device__ void init(int M, int N, int G_, int c_) { nM = M / BM; nN = N / BM; nwg = nM * nN; G = G_; c = c_; }
    __host__ __device__ bool next(int i, Unit& u) const {
        const long L = (long)i * G + c; if (L >= nwg) return false;
        int wgid = (int)L; { const int q = nwg / NXCD, r = nwg % NXCD, xcd = wgid % NXCD, off = wgid / NXCD; wgid = (xcd < r ? xcd * (q + 1) : r * (q + 1) + (xcd - r) * q) + off; }
        const int nig = WGM * nN, gid = wgid / nig, fm = gid * WGM, gsz = (nM - fm) < WGM ? (nM - fm) : WGM;
        u.pm = fm + ((wgid % nig) % gsz); u.pn = (wgid % nig) / gsz; return true;
    }
    __device__ __forceinline__ void a_ready(const Unit&) const {}
    __device__ __forceinline__ void done(const Unit&) const {}
};

__device__ __forceinline__ unsigned cvt_pk_bf16(float lo, float hi) { unsigned r; asm volatile("v_cvt_pk_bf16_f32 %0, %1, %2" : "=v"(r) : "v"(lo), "v"(hi)); return r; }
typedef float f32x2 __attribute__((ext_vector_type(2)));
__device__ __forceinline__ f32x2 gelu_pk(f32x2 v) {
    const f32x2 av = __builtin_elementwise_abs(v), d = av * 0.2316418882f + 1.0f;
    f32x2 t; t.x = __builtin_amdgcn_rcpf(d.x); t.y = __builtin_amdgcn_rcpf(d.y);
    f32x2 q = t * 0.5307027145f + (-0.7265760135f); q = q * t + 0.7107068705f; q = q * t + (-0.142248368f); q = q * t + 0.127414796f; q = q * t;
    const f32x2 s = (v * v) * (-0.72134752044f);
    f32x2 e; e.x = __builtin_amdgcn_exp2f(s.x); e.y = __builtin_amdgcn_exp2f(s.y);
    const f32x2 m = v * (q * e), r = v - m;
    f32x2 o; o.x = v.x < 0.f ? m.x : r.x; o.y = v.y < 0.f ? m.y : r.y; return o;
}

template <int ACT  > struct EpiBf16 {
    static constexpr bool PERM = true, AFTER_DRAIN = false; static_assert(ACT == 0 || ACT == 1, "EpiBf16: ACT is 0 (none) or 1 (gelu_pk)");
    bf16_t* O; int ldc; const float* bias; int split_cols; size_t split_stride; float scale0;
    __device__ __forceinline__ void operator()(const f32x4 (&acc)[2][2][4][2], const Unit& u, int wr, int wc, int fr, int fq) const {
        const int row0 = u.pm * BM + wr * 64 + fr; int colt = u.pn * BM; bf16_t* base = O;
        float sc = 1.f; if (split_cols) { const int t = colt / split_cols; base += (size_t)t * split_stride; colt -= t * split_cols; if (t == 0) sc = scale0; }
        const int col0 = colt + wc * 32 + 8 * fq, bcol0 = u.pn * BM + wc * 32 + 8 * fq;
        f32x4 bv[2][2];
#pragma unroll
        for (int bj = 0; bj < 2; ++bj)
#pragma unroll
            for (int n = 0; n < 2; ++n) bv[bj][n] = bias ? *(const f32x4*)(bias + bcol0 + bj * HALF + 4 * n) : (f32x4){0.f, 0.f, 0.f, 0.f};
#pragma unroll
        for (int ai = 0; ai < 2; ++ai)
#pragma unroll
            for (int m = 0; m < 4; ++m) { bf16_t* rowp = base + (size_t)(row0 + ai * HALF + m * 16) * ldc + col0;
#pragma unroll
                for (int bj = 0; bj < 2; ++bj) { f32x4 v0 = acc[ai][bj][m][0] + bv[bj][0], v1 = acc[ai][bj][m][1] + bv[bj][1];
                    if (ACT == 1) { f32x2 a = gelu_pk((f32x2){v0[0], v0[1]}), b = gelu_pk((f32x2){v0[2], v0[3]}), c = gelu_pk((f32x2){v1[0], v1[1]}), d = gelu_pk((f32x2){v1[2], v1[3]});
                        v0 = (f32x4){a.x, a.y, b.x, b.y}; v1 = (f32x4){c.x, c.y, d.x, d.y}; }
                    v0 = v0 * sc; v1 = v1 * sc; u32x4 w; w.x = cvt_pk_bf16(v0[0], v0[1]); w.y = cvt_pk_bf16(v0[2], v0[3]); w.z = cvt_pk_bf16(v1[0], v1[1]); w.w = cvt_pk_bf16(v1[2], v1[3]);
                    *(u32x4*)(rowp + bj * HALF) = w; } }
    }
};
typedef unsigned u32x2 __attribute__((ext_vector_type(2)));
typedef __bf16 bf16x2m_t __attribute__((ext_vector_type(2)));
__device__ __forceinline__ unsigned cvt_pk_m(float lo, float hi) { f32x2 v = {lo, hi}; bf16x2m_t b = __builtin_convertvector(v, bf16x2m_t); return __builtin_bit_cast(unsigned, b); }
__device__ __forceinline__ float silu_f(float g) { return g * __builtin_amdgcn_rcpf(1.0f + __expf(-g)); }

__device__ __forceinline__ float rstd_of(const float* ssq, int row) { return __builtin_amdgcn_rsqf(ssq[row] * (1.0f / 1024.0f) + 1e-6f); }

struct EpiScaleBias {
    static constexpr bool PERM = true, AFTER_DRAIN = false;
    bf16_t* O; int ldc; const float* ssq; const float* shw; int ldshw;
    struct Pre { f32x4 bv[2][2]; float sq[2][4]; };
    __device__ __forceinline__ void prefetch(Pre& p, const Unit& u, int wr, int wc, int fr, int fq) const {
        const int b = u.pm >> 4;
        const int row0 = u.pm * BM + wr * 64 + fr, col0 = u.pn * BM + wc * 32 + 8 * fq;
#pragma unroll
        for (int bj = 0; bj < 2; ++bj)
#pragma unroll
            for (int n = 0; n < 2; ++n) p.bv[bj][n] = *(const f32x4*)(shw + (size_t)b * ldshw + col0 + bj * HALF + 4 * n);
#pragma unroll
        for (int ai = 0; ai < 2; ++ai)
#pragma unroll
            for (int m = 0; m < 4; ++m) p.sq[ai][m] = ssq[row0 + ai * HALF + m * 16];
    }
    __device__ __forceinline__ void operator()(const f32x4 (&acc)[2][2][4][2], const Unit& u, int wr, int wc, int fr, int fq, const Pre& p) const {
        const int row0 = u.pm * BM + wr * 64 + fr, col0 = u.pn * BM + wc * 32 + 8 * fq;
        const f32x4 (&bv)[2][2] = p.bv;
#pragma unroll
        for (int ai = 0; ai < 2; ++ai)
#pragma unroll
            for (int m = 0; m < 4; ++m) {
                const int row = row0 + ai * HALF + m * 16;
                const float r = __builtin_amdgcn_rsqf(p.sq[ai][m] * (1.0f / 1024.0f) + 1e-6f);
                bf16_t* rowp = O + (size_t)row * ldc + col0;
#pragma unroll
                for (int bj = 0; bj < 2; ++bj) {
                    const f32x4 v0 = acc[ai][bj][m][0] * r + bv[bj][0], v1 = acc[ai][bj][m][1] * r + bv[bj][1];
                    u32x4 w; w.x = cvt_pk_m(v0[0], v0[1]); w.y = cvt_pk_m(v0[2], v0[3]); w.z = cvt_pk_m(v1[0], v1[1]); w.w = cvt_pk_m(v1[2], v1[3]);
                    *(u32x4*)(rowp + bj * HALF) = w;
                }
            }
    }
};

struct EpiScaleBiasT {
    static constexpr bool PERM = true, AFTER_DRAIN = false;
    bf16_t* O; int ldc; const float* ssq; const float* shw; int ldshw;
    struct Pre { f32x4 q[2][2]; float bs[2][4]; };
    __device__ __forceinline__ void prefetch(Pre& p, const Unit& u, int wr, int wc, int fr, int fq) const {
        const int b = u.pn >> 4;
        const int row0 = u.pm * BM + wr * 64 + fr, col0 = u.pn * BM + wc * 32 + 8 * fq;
#pragma unroll
        for (int bj = 0; bj < 2; ++bj)
#pragma unroll
            for (int n = 0; n < 2; ++n) p.q[bj][n] = *(const f32x4*)(ssq + col0 + bj * HALF + 4 * n);
#pragma unroll
        for (int ai = 0; ai < 2; ++ai)
#pragma unroll
            for (int m = 0; m < 4; ++m) p.bs[ai][m] = shw[(size_t)b * ldshw + row0 + ai * HALF + m * 16];
    }
    __device__ __forceinline__ void operator()(const f32x4 (&acc)[2][2][4][2], const Unit& u, int wr, int wc, int fr, int fq, const Pre& p) const {
        const int row0 = u.pm * BM + wr * 64 + fr, col0 = u.pn * BM + wc * 32 + 8 * fq;
        f32x4 rv[2][2];
#pragma unroll
        for (int bj = 0; bj < 2; ++bj)
#pragma unroll
            for (int n = 0; n < 2; ++n) {
#pragma unroll
                for (int i = 0; i < 4; ++i) rv[bj][n][i] = __builtin_amdgcn_rsqf(p.q[bj][n][i] * (1.0f / 1024.0f) + 1e-6f); }
#pragma unroll
        for (int ai = 0; ai < 2; ++ai)
#pragma unroll
            for (int m = 0; m < 4; ++m) {
                const int row = row0 + ai * HALF + m * 16;
                const float bs = p.bs[ai][m];
                bf16_t* rowp = O + (size_t)row * ldc + col0;
#pragma unroll
                for (int bj = 0; bj < 2; ++bj) {
                    const f32x4 v0 = acc[ai][bj][m][0] * rv[bj][0] + bs, v1 = acc[ai][bj][m][1] * rv[bj][1] + bs;
                    u32x4 w; w.x = cvt_pk_m(v0[0], v0[1]); w.y = cvt_pk_m(v0[2], v0[3]); w.z = cvt_pk_m(v1[0], v1[1]); w.w = cvt_pk_m(v1[2], v1[3]);
                    *(u32x4*)(rowp + bj * HALF) = w;
                }
            }
    }
};

struct EpiSwiGLU {
    static constexpr bool PERM = true, AFTER_DRAIN = false;
    bf16_t* O; int ldc; const float* ssq; const float* shwg; const float* shwu; int ldshw;
    struct Pre { float sq[2][4]; };
    __device__ __forceinline__ void prefetch(Pre& p, const Unit& u, int wr, int wc, int fr, int fq) const {
        const int row0 = u.pm * BM + wr * 64 + fr;
#pragma unroll
        for (int ai = 0; ai < 2; ++ai)
#pragma unroll
            for (int m = 0; m < 4; ++m) p.sq[ai][m] = ssq[row0 + ai * HALF + m * 16];
    }
    __device__ __forceinline__ void operator()(const f32x4 (&acc)[2][2][4][2], const Unit& u, int wr, int wc, int fr, int fq, const Pre& p) const {
        const int row0 = u.pm * BM + wr * 64 + fr, col0 = u.pn * HALF + wc * 32 + 8 * fq;
        const int b = u.pm >> 4;
        const f32x4 bg0 = *(const f32x4*)(shwg + (size_t)b * ldshw + col0), bg1 = *(const f32x4*)(shwg + (size_t)b * ldshw + col0 + 4);
        const f32x4 bu0 = *(const f32x4*)(shwu + (size_t)b * ldshw + col0), bu1 = *(const f32x4*)(shwu + (size_t)b * ldshw + col0 + 4);
#pragma unroll
        for (int ai = 0; ai < 2; ++ai)
#pragma unroll
            for (int m = 0; m < 4; ++m) {
                const int row = row0 + ai * HALF + m * 16;
                const float r = __builtin_amdgcn_rsqf(p.sq[ai][m] * (1.0f / 1024.0f) + 1e-6f);
                bf16_t* rowp = O + (size_t)row * ldc + col0;
                const f32x4 g0 = acc[ai][0][m][0] * r + bg0, g1 = acc[ai][0][m][1] * r + bg1, u0 = acc[ai][1][m][0] * r + bu0, u1 = acc[ai][1][m][1] * r + bu1;
                const f32x4 t0 = g0 * (-1.4426950408889634f), t1 = g1 * (-1.4426950408889634f);
                f32x4 e0, e1;
#pragma unroll
                for (int i = 0; i < 4; ++i) { e0[i] = __builtin_amdgcn_exp2f(t0[i]); e1[i] = __builtin_amdgcn_exp2f(t1[i]); }
                const f32x4 d0 = e0 + 1.0f, d1 = e1 + 1.0f;
                f32x4 r0, r1;
#pragma unroll
                for (int i = 0; i < 4; ++i) { r0[i] = __builtin_amdgcn_rcpf(d0[i]); r1[i] = __builtin_amdgcn_rcpf(d1[i]); }
                const f32x4 h0 = (g0 * u0) * r0, h1 = (g1 * u1) * r1;
                u32x4 w; w.x = cvt_pk_m(h0[0], h0[1]); w.y = cvt_pk_m(h0[2], h0[3]); w.z = cvt_pk_m(h1[0], h1[1]); w.w = cvt_pk_m(h1[2], h1[3]);
                *(u32x4*)rowp = w;
            }
    }
};

struct EpiResidNext {
    static constexpr bool PERM = true, AFTER_DRAIN = false;
    const float* base; float* out; const float* gate; bf16_t* XN; const float* gnorm; const float* scn; float* ssq; int nxt;
    struct Pre { };
    __device__ __forceinline__ void prefetch(Pre&, const Unit&, int, int, int, int) const {}
    __device__ __forceinline__ void operator()(const f32x4 (&acc)[2][2][4][2], const Unit& u, int wr, int wc, int fr, int fq, const Pre&) const {
        const int b = u.pm >> 4;
        const int col0 = u.pn * BM + wc * 32 + 8 * fq;
        f32x4 gv[2][2], gm[2][2];
#pragma unroll
        for (int bj = 0; bj < 2; ++bj)
#pragma unroll
            for (int n = 0; n < 2; ++n) {
                gv[bj][n] = *(const f32x4*)(gate + (size_t)b * 6144 + col0 + bj * HALF + 4 * n);
                gm[bj][n] = (f32x4){0.f, 0.f, 0.f, 0.f};
                if (nxt) gm[bj][n] = *(const f32x4*)(gnorm + col0 + bj * HALF + 4 * n) * (*(const f32x4*)(scn + (size_t)b * 6144 + col0 + bj * HALF + 4 * n) + 1.0f);
            }
#pragma unroll
        for (int ai = 0; ai < 2; ++ai)
#pragma unroll
            for (int mp = 0; mp < 2; ++mp) {
                f32x4 bs[2][2][2];
#pragma unroll
                for (int mm = 0; mm < 2; ++mm) {
                    const size_t off = (size_t)(u.pm * BM + ai * HALF + wr * 64 + (2 * mp + mm) * 16 + fr) * 1024 + col0;
#pragma unroll
                    for (int bj = 0; bj < 2; ++bj) { bs[mm][bj][0] = *(const f32x4*)(base + off + bj * HALF); bs[mm][bj][1] = *(const f32x4*)(base + off + bj * HALF + 4); }
                }
                float ssm[2];
#pragma unroll
                for (int mm = 0; mm < 2; ++mm) {
                    const int m = 2 * mp + mm;
                    const int row = u.pm * BM + ai * HALF + wr * 64 + m * 16 + fr;
                    const size_t off = (size_t)row * 1024 + col0;
                    float ss = 0.f;
#pragma unroll
                    for (int bj = 0; bj < 2; ++bj) {
                        const f32x4 o0 = bs[mm][bj][0] + gv[bj][0] * acc[ai][bj][m][0], o1 = bs[mm][bj][1] + gv[bj][1] * acc[ai][bj][m][1];
                        *(f32x4*)(out + off + bj * HALF) = o0; *(f32x4*)(out + off + bj * HALF + 4) = o1;
                        if (nxt) {
                            ss += ((o0[0] * o0[0] + o0[1] * o0[1]) + (o0[2] * o0[2] + o0[3] * o0[3])) + ((o1[0] * o1[0] + o1[1] * o1[1]) + (o1[2] * o1[2] + o1[3] * o1[3]));
                            const f32x4 x0 = o0 * gm[bj][0], x1 = o1 * gm[bj][1];
                            u32x4 w; w.x = cvt_pk_m(x0[0], x0[1]); w.y = cvt_pk_m(x0[2], x0[3]); w.z = cvt_pk_m(x1[0], x1[1]); w.w = cvt_pk_m(x1[2], x1[3]);
                            *(u32x4*)(XN + off + bj * HALF) = w;
                        }
                    }
                    ss += __shfl_xor(ss, 16); ss += __shfl_xor(ss, 32); ssm[mm] = ss;
                }
                if (nxt && fq == 0) {
#pragma unroll
                    for (int mm = 0; mm < 2; ++mm) unsafeAtomicAdd(ssq + (u.pm * BM + ai * HALF + wr * 64 + (2 * mp + mm) * 16 + fr), ssm[mm]);
                }
            }
    }
};

template <class Epi, class Sched, bool ALIGN_EPI = false, bool SP2 = false>
__device__ __forceinline__ void gemm_phase(PG8_LAS unsigned char* lds, const Gemm g, const Sched& S, const Epi& E, int tid_in) {
    int tid_ = tid_in; asm volatile("" : "+v"(tid_));
    const int tid = tid_, wid = __builtin_amdgcn_readfirstlane(tid >> 6), lane = tid & 63, wr = wid >> 2, wc = wid & 3, fr = lane & 15, fq = lane >> 4;
    const int K = g.K, nt = K / BK;
    unsigned voffA[2], voffB[2];
#pragma unroll
    for (int i = 0; i < 2; ++i) { int R, C; stage_rc(tid * 16 + i * 8192, R, C); const int Rb = Epi::PERM ? ((R & ~31) + perm32(R & 31)) : R;
        voffA[i] = (unsigned)(R * K + C) * 2u; voffB[i] = (unsigned)(Rb * K + C) * 2u; }
    const size_t kstep = (size_t)(BK * 2);
    const size_t hstep = (size_t)HALF * K * 2;
    const size_t tstep = 2 * hstep;
    const unsigned ldsw = (unsigned)wid * 1024u;
    const int aoff = lds_byte(wr * 64 + fr, fq * 8), boff = lds_byte(wc * 32 + fr, fq * 8);
#define PG8_SA(b, h) (((b) * 2 + (h)) * HTB)
#define PG8_SB(b, h) ((4 + (b) * 2 + (h)) * HTB)
#define PG8_STAGE(bufoff, gbase, voff) do { _Pragma("unroll") for (int _i = 0; _i < 2; ++_i) \
        __builtin_amdgcn_global_load_lds((const unsigned*)((const char*)(gbase) + (voff)[_i]), (PG8_LAS unsigned*)(lds + (bufoff) + ldsw + _i * 8192), 16, 0, 0); } while (0)
#define PG8_LDA(dst, b, h) do { _Pragma("unroll") for (int m = 0; m < 4; ++m) _Pragma("unroll") for (int k = 0; k < 2; ++k) dst[m][k] = *(const PG8_LAS bf16x8*)(lds + PG8_SA(b, h) + aoff + m * 2048 + k * 1024); } while (0)
#define PG8_LDB(dst, b, h) do { _Pragma("unroll") for (int n = 0; n < 2; ++n) _Pragma("unroll") for (int k = 0; k < 2; ++k) dst[n][k] = *(const PG8_LAS bf16x8*)(lds + PG8_SB(b, h) + boff + n * 2048 + k * 1024); } while (0)
#define PG8_MMA(ai, bj, At, Bt) do { __builtin_amdgcn_s_setprio(1); _Pragma("unroll") for (int m = 0; m < 4; ++m) _Pragma("unroll") for (int n = 0; n < 2; ++n) _Pragma("unroll") for (int k = 0; k < 2; ++k) \
        acc[ai][bj][m][n] = __builtin_amdgcn_mfma_f32_16x16x32_bf16(Bt[n][k], At[m][k], acc[ai][bj][m][n], 0, 0, 0); __builtin_amdgcn_s_setprio(0); } while (0)
#define PG8_WAIT_V(n) asm volatile("s_waitcnt vmcnt(" #n ")" ::: "memory")
#define PG8_WAIT_L(n) asm volatile("s_waitcnt lgkmcnt(" #n ")" ::: "memory")
#define PG8_BAR __builtin_amdgcn_s_barrier()
#define PG8_SCHED __builtin_amdgcn_sched_barrier(0)
    Unit cur, nxt; int ui = 0;
    if (!S.next(0, cur)) return;
    f32x4 acc[2][2][4][2];
#pragma unroll
    for (int a = 0; a < 2; ++a)
#pragma unroll
        for (int b = 0; b < 2; ++b)
#pragma unroll
            for (int m = 0; m < 4; ++m)
#pragma unroll
                for (int n = 0; n < 2; ++n) acc[a][b][m][n] = (f32x4){0.f, 0.f, 0.f, 0.f};
    bf16x8 At[4][2], B0[2][2], B1[2][2];
    const char* cA = (const char*)g.A + (size_t)cur.pm * tstep; const char* cB = (const char*)g.Bt + (size_t)cur.pn * tstep;
    S.a_ready(cur);
    if constexpr (SP2) {
        PG8_STAGE(PG8_SB(0, 0), cB, voffB); PG8_STAGE(PG8_SB(0, 1), cB + hstep, voffB); PG8_STAGE(PG8_SA(0, 0), cA, voffA); PG8_STAGE(PG8_SA(0, 1), cA + hstep, voffA);
        if (wr == 1) PG8_BAR;
        PG8_WAIT_V(2); PG8_BAR;
        PG8_STAGE(PG8_SB(1, 0), cB + kstep, voffB); PG8_STAGE(PG8_SA(1, 0), cA + kstep, voffA); PG8_STAGE(PG8_SB(1, 1), cB + hstep + kstep, voffB);
        PG8_WAIT_V(6); PG8_BAR;
    } else {
        PG8_STAGE(PG8_SB(0, 0), cB, voffB); PG8_STAGE(PG8_SA(0, 0), cA, voffA); PG8_STAGE(PG8_SB(0, 1), cB + hstep, voffB); PG8_STAGE(PG8_SA(0, 1), cA + hstep, voffA);
        if (wr == 1) PG8_BAR;
        PG8_WAIT_V(4); PG8_BAR;
        PG8_STAGE(PG8_SB(1, 0), cB + kstep, voffB); PG8_STAGE(PG8_SA(1, 0), cA + kstep, voffA); PG8_STAGE(PG8_SB(1, 1), cB + hstep + kstep, voffB);
        PG8_WAIT_V(6); PG8_BAR;
    }
    for (;;) {
        const bool has_next = S.next(ui + 1, nxt);
        typename Epi::Pre pre; E.prefetch(pre, cur, wr, wc, fr, fq);
        const char* nA = has_next ? (const char*)g.A + (size_t)nxt.pm * tstep : cA; const char* nB = has_next ? (const char*)g.Bt + (size_t)nxt.pn * tstep : cB;
        for (int t = 0; t < nt; t += 2) {
            const bool last = (t == nt - 2);
            const char* a1 = cA + (size_t)(t + 1) * kstep;
            const char* a2 = last ? nA : cA + (size_t)(t + 2) * kstep; const char* b2 = last ? nB : cB + (size_t)(t + 2) * kstep;
            const char* a3 = a2 + kstep; const char* b3 = b2 + kstep;
            if (last && has_next) S.a_ready(nxt);
            if constexpr (SP2) {
            PG8_LDB(B0, 0, 0); PG8_LDB(B1, 0, 1); PG8_SCHED; PG8_LDA(At, 0, 0); PG8_STAGE(PG8_SA(1, 1), a1 + hstep, voffA);
            PG8_WAIT_V(8); PG8_WAIT_L(0); PG8_BAR; PG8_MMA(0, 0, At, B0); PG8_MMA(0, 1, At, B1); PG8_BAR; PG8_SCHED;
            PG8_LDA(At, 0, 1); PG8_STAGE(PG8_SB(0, 0), b2, voffB); PG8_STAGE(PG8_SB(0, 1), b2 + hstep, voffB); PG8_STAGE(PG8_SA(0, 0), a2, voffA);
            PG8_WAIT_V(8); PG8_WAIT_L(0); PG8_BAR; PG8_MMA(1, 0, At, B0); PG8_MMA(1, 1, At, B1); PG8_BAR; PG8_SCHED;
            PG8_LDB(B0, 1, 0); PG8_LDB(B1, 1, 1); PG8_SCHED; PG8_LDA(At, 1, 0); PG8_STAGE(PG8_SA(0, 1), a2 + hstep, voffA);
            PG8_WAIT_V(8); PG8_WAIT_L(0); PG8_BAR; PG8_MMA(0, 0, At, B0); PG8_MMA(0, 1, At, B1); PG8_BAR; PG8_SCHED;
            PG8_LDA(At, 1, 1); PG8_STAGE(PG8_SB(1, 0), b3, voffB); PG8_STAGE(PG8_SB(1, 1), b3 + hstep, voffB); PG8_STAGE(PG8_SA(1, 0), a3, voffA);
            PG8_WAIT_V(8); PG8_WAIT_L(0); PG8_BAR; PG8_MMA(1, 0, At, B0); PG8_MMA(1, 1, At, B1); PG8_BAR; PG8_SCHED;
            } else {
            PG8_LDB(B0, 0, 0); PG8_SCHED; PG8_LDA(At, 0, 0); PG8_STAGE(PG8_SA(1, 1), a1 + hstep, voffA);
            PG8_WAIT_L(8); PG8_BAR; PG8_WAIT_L(0); PG8_MMA(0, 0, At, B0); PG8_BAR; PG8_SCHED;
            PG8_LDB(B1, 0, 1); PG8_STAGE(PG8_SB(0, 0), b2, voffB);
            PG8_BAR; PG8_WAIT_L(0); PG8_MMA(0, 1, At, B1); PG8_BAR;
            PG8_LDA(At, 0, 1); PG8_STAGE(PG8_SA(0, 0), a2, voffA);
            PG8_BAR; PG8_WAIT_L(0); PG8_MMA(1, 0, At, B0); PG8_BAR; PG8_SCHED;
            PG8_STAGE(PG8_SB(0, 1), b2 + hstep, voffB);
            PG8_WAIT_V(6); PG8_BAR; PG8_MMA(1, 1, At, B1); PG8_BAR;
            PG8_LDB(B0, 1, 0); PG8_SCHED; PG8_LDA(At, 1, 0); PG8_STAGE(PG8_SA(0, 1), a2 + hstep, voffA);
            PG8_WAIT_L(8); PG8_BAR; PG8_WAIT_L(0); PG8_MMA(0, 0, At, B0); PG8_BAR; PG8_SCHED;
            PG8_LDB(B1, 1, 1); PG8_STAGE(PG8_SB(1, 0), b3, voffB);
            PG8_BAR; PG8_WAIT_L(0); PG8_MMA(0, 1, At, B1); PG8_BAR;
            PG8_LDA(At, 1, 1); PG8_STAGE(PG8_SA(1, 0), a3, voffA);
            PG8_BAR; PG8_WAIT_L(0); PG8_MMA(1, 0, At, B0); PG8_BAR; PG8_SCHED;
            PG8_STAGE(PG8_SB(1, 1), b3 + hstep, voffB);
            PG8_WAIT_V(6); PG8_BAR; PG8_MMA(1, 1, At, B1); PG8_BAR;
            }
        }
        if constexpr (ALIGN_EPI) { if (wr == 0) PG8_BAR; }
        if constexpr (!Epi::AFTER_DRAIN) { E(acc, cur, wr, wc, fr, fq, pre); S.done(cur); }
        if (!has_next) break;
#pragma unroll
        for (int a = 0; a < 2; ++a)
#pragma unroll
            for (int b = 0; b < 2; ++b)
#pragma unroll
                for (int m = 0; m < 4; ++m)
#pragma unroll
                    for (int n = 0; n < 2; ++n) acc[a][b][m][n] = (f32x4){0.f, 0.f, 0.f, 0.f};
        cur = nxt; cA = nA; cB = nB; ++ui;
        if constexpr (ALIGN_EPI) { if (wr == 1) PG8_BAR; }
    }
    PG8_WAIT_V(0);
    if constexpr (!ALIGN_EPI) { if (wr == 0) PG8_BAR; }
    PG8_BAR;
    if constexpr (Epi::AFTER_DRAIN) { E.fused(acc, cur, wr, wc, fr, fq, lds, wid, lane); S.done(cur); }
#undef PG8_SA
#undef PG8_SB
#undef PG8_STAGE
#undef PG8_LDA
#undef PG8_LDB
#undef PG8_MMA
#undef PG8_WAIT_V
#undef PG8_WAIT_L
#undef PG8_BAR
#undef PG8_SCHED
}
}
namespace mk {
using pg8::bf16_t;
typedef short bf16x8 __attribute__((ext_vector_type(8)));
typedef float f32x4 __attribute__((ext_vector_type(4)));
typedef float f32x2 __attribute__((ext_vector_type(2)));
typedef float f32x16 __attribute__((ext_vector_type(16)));
typedef unsigned u32x4 __attribute__((ext_vector_type(4)));
typedef unsigned u32x2 __attribute__((ext_vector_type(2)));
#define LAS __attribute__((address_space(3)))

constexpr int NB = 4, SEQ = 4096, DM = 1024, TOK = NB * SEQ, DFF = 2816, EVIN = 3584, NL = 4;
constexpr float EPS = 1e-6f;
constexpr size_t MiB = 1u << 20;
constexpr size_t WS_CTL = 0, CTL_BYTES = 1 * MiB, WS_MOD = 65536;
constexpr size_t WS_ROPE = 1 * MiB;
constexpr size_t W_EVIN = 3 * MiB;
constexpr size_t W_EVOUT = W_EVIN + 2 * (size_t)EVIN * DM * 2;
constexpr size_t W_ODQKV = W_EVOUT + 2 * (size_t)DM * DM * 2;
constexpr size_t W_ODOUT = W_ODQKV + 2 * (size_t)3 * DM * DM * 2;
constexpr size_t W_GU = W_ODOUT + 2 * (size_t)DM * DM * 2;
constexpr size_t W_DN = W_GU + 4 * (size_t)2 * DFF * DM * 2;
constexpr size_t W_END = W_DN + 4 * (size_t)DFF * DM * 2;
static_assert(W_END == 103 * MiB, "weight map");
constexpr size_t WS_XN = 103 * MiB, WS_PROJ = 135 * MiB, WS_MIX = 247 * MiB, WS_KV = 279 * MiB, WS_ST = 343 * MiB, WS_SHW = 375 * MiB, WS_SSQ = 376 * MiB, WS_END = 377 * MiB;
constexpr int LDSHW = 3584;
constexpr int LDS_BYTES = 147456, LDS_EXTRA = 131072;

__device__ __forceinline__ float bflo(unsigned w) { return __uint_as_float(w << 16); }
__device__ __forceinline__ float bfhi(unsigned w) { return __uint_as_float(w & 0xffff0000u); }
typedef __bf16 bf16x2_t __attribute__((ext_vector_type(2)));
__device__ __forceinline__ unsigned pk2(float lo, float hi) { f32x2 v = {lo, hi}; bf16x2_t b = __builtin_convertvector(v, bf16x2_t); return __builtin_bit_cast(unsigned, b); }
__device__ __forceinline__ int crow(int r, int hi) { return (r & 3) + 8 * (r >> 2) + 4 * hi; }
#define WG_BARRIER() do { asm volatile("s_waitcnt vmcnt(0) lgkmcnt(0)" ::: "memory"); __builtin_amdgcn_s_barrier(); asm volatile("" ::: "memory"); } while (0)
#define MFMA32(a, b, c) __builtin_amdgcn_mfma_f32_32x32x16_bf16((a), (b), (c), 0, 0, 0)

__constant__ float LOG2G[4] = {-0.04580368961312479f, -0.02272007650008353f, -0.011315313227834146f, -0.005646563141142063f};
__constant__ float DEC64[4] = {0.13108403247847505f, 0.36498652424390743f, 0.6053409914436964f, 0.7784196093554429f};

__device__ __forceinline__ void transpose_item(const float* W, int K, int N, bf16_t* WT, int mode, LAS float* scr, int item, int lane) {
    const int nblk = N / 32, kb = item / nblk, nb = item % nblk, k0 = 64 * kb, n0 = 32 * nb;
    const int r0 = (mode == 0) ? n0 : ((n0 >> 7) * 256 + (n0 & 127) + (mode == 2 ? 128 : 0));
    f32x4 v[8];
    const float* src = W + (size_t)(k0 + (lane >> 3)) * N + n0 + 4 * (lane & 7);
#pragma unroll
    for (int i = 0; i < 8; ++i) v[i] = *(const f32x4*)(src + (size_t)(8 * i) * N);
#pragma unroll
    for (int i = 0; i < 8; ++i) { LAS float* d = scr + ((lane >> 3) + 8 * i) * 33 + 4 * (lane & 7); d[0] = v[i][0]; d[1] = v[i][1]; d[2] = v[i][2]; d[3] = v[i][3]; }
    asm volatile("s_waitcnt lgkmcnt(0)" ::: "memory");
    const int c = lane & 7;
#pragma unroll
    for (int j = 0; j < 4; ++j) { const int n = (lane >> 3) + 8 * j; const LAS float* s = scr + (8 * c) * 33 + n;
        u32x4 o; o.x = pk2(s[0 * 33], s[1 * 33]); o.y = pk2(s[2 * 33], s[3 * 33]); o.z = pk2(s[4 * 33], s[5 * 33]); o.w = pk2(s[6 * 33], s[7 * 33]);
        *(u32x4*)(WT + (size_t)(r0 + n) * K + k0 + 8 * c) = o; }
    asm volatile("s_waitcnt lgkmcnt(0)" ::: "memory");
}

__device__ __forceinline__ void gemv4_item(const float* W, int ldw, const float* kvec, int kstride, bool do_silu, float* out, int ostride, const float* bias, LAS unsigned char* lds, int tid, int wave, int lane) {
    f32x4 acc[4];
#pragma unroll
    for (int b = 0; b < 4; ++b) acc[b] = (f32x4){0.f, 0.f, 0.f, 0.f};
#pragma unroll 1
    for (int kh = 0; kh < 2; ++kh) {
        const int kbase = wave * 128 + kh * 64;
        float ca[4];
#pragma unroll
        for (int b = 0; b < 4; ++b) { const float cv = kvec[(size_t)b * kstride + kbase + lane]; ca[b] = do_silu ? pg8::silu_f(cv) : cv; }
        const float* wp = W + (size_t)kbase * ldw + 4 * lane;
#pragma unroll 8
        for (int k = 0; k < 64; ++k) {
            const f32x4 w = *(const f32x4*)(wp + (size_t)k * ldw);
#pragma unroll
            for (int b = 0; b < 4; ++b) { const float cb_ = __shfl(ca[b], k); acc[b] += w * cb_; }
        }
    }
    LAS float* red = (LAS float*)lds;
#pragma unroll
    for (int b = 0; b < 4; ++b) *(LAS f32x4*)(red + (wave * 4 + b) * 256 + 4 * lane) = acc[b];
    WG_BARRIER();
#pragma unroll
    for (int q = 0; q < 2; ++q) {
        const int o = tid + 512 * q, b = o >> 8, col = o & 255;
        float sum = bias ? bias[col] : 0.f;
#pragma unroll
        for (int w = 0; w < 8; ++w) sum += red[(w * 4 + b) * 256 + col];
        out[(size_t)b * ostride + col] = sum;
    }
    WG_BARRIER();
}

struct Ptrs {
    const float *x, *c, *ada_w, *ada_b, *norm_mix_g, *norm_ffn_g, *ev_w_in, *ev_conv_w, *ev_ret_norm_g, *ev_w_out, *od_w_qkv, *od_q_norm_g, *od_k_norm_g, *od_w_out, *ffn_w_gate, *ffn_w_up, *ffn_w_down;
};

__device__ __forceinline__ void convert_layer(const Ptrs& p, unsigned char* ws, LAS unsigned char* lds, int l, int first, int stride, int wave, int lane) {
    LAS float* scr = (LAS float*)(lds + wave * 16384);
    constexpr int I_EVIN = 16 * (EVIN / 32), I_SQ = 16 * 32, I_QKV = 16 * 96, I_G = 16 * (DFF / 32), I_D = (DFF / 64) * 32;
    const int jl = l >> 1, odd = l & 1;
    const int n_in = odd ? I_QKV : I_EVIN, total = n_in + I_SQ + 2 * I_G + I_D;
    for (int it = first; it < total; it += stride) {
        int r = it;
        if (r < n_in) {
            if (odd) transpose_item(p.od_w_qkv + (size_t)jl * DM * 3 * DM, DM, 3 * DM, (bf16_t*)(ws + W_ODQKV) + (size_t)jl * 3 * DM * DM, 0, scr, r, lane);
            else     transpose_item(p.ev_w_in + (size_t)jl * DM * EVIN, DM, EVIN, (bf16_t*)(ws + W_EVIN) + (size_t)jl * EVIN * DM, 0, scr, r, lane);
            continue; }
        r -= n_in;
        if (r < I_SQ) {
            if (odd) transpose_item(p.od_w_out + (size_t)jl * DM * DM, DM, DM, (bf16_t*)(ws + W_ODOUT) + (size_t)jl * DM * DM, 0, scr, r, lane);
            else     transpose_item(p.ev_w_out + (size_t)jl * DM * DM, DM, DM, (bf16_t*)(ws + W_EVOUT) + (size_t)jl * DM * DM, 0, scr, r, lane);
            continue; }
        r -= I_SQ;
        if (r < I_G) { transpose_item(p.ffn_w_gate + (size_t)l * DM * DFF, DM, DFF, (bf16_t*)(ws + W_GU) + (size_t)l * 2 * DFF * DM, 1, scr, r, lane); continue; } r -= I_G;
        if (r < I_G) { transpose_item(p.ffn_w_up + (size_t)l * DM * DFF, DM, DFF, (bf16_t*)(ws + W_GU) + (size_t)l * 2 * DFF * DM, 2, scr, r, lane); continue; } r -= I_G;
        transpose_item(p.ffn_w_down + (size_t)l * DFF * DM, DFF, DM, (bf16_t*)(ws + W_DN) + (size_t)l * DM * DFF, 0, scr, r, lane);
    }
}

__device__ __forceinline__ void prologue(const Ptrs& p, unsigned char* ws, LAS unsigned char* lds, int bid, int G, int tid, int wave, int lane) {
    const int gw = bid * 8 + wave, NGW = G * 8;
    float* mod = (float*)(ws + WS_MOD);
    for (int it = bid; it < 4 * 24; it += G) {
        const int cb = it % 24, l = it / 24;
        gemv4_item(p.ada_w + (size_t)l * DM * 6144 + cb * 256, 6144, p.c, DM, true, mod + (size_t)l * 4 * 6144 + cb * 256, 6144, p.ada_b + l * 6144 + cb * 256, lds, tid, wave, lane);
    }
    { float* ssq = (float*)(ws + WS_SSQ); for (int e = bid * 512 + tid; e < 8 * TOK; e += G * 512) ssq[e] = 0.f; }
    {
        f32x2* rope = (f32x2*)(ws + WS_ROPE);
        for (int e = bid * 512 + tid; e < SEQ * 64; e += G * 512) {
            const int pos = e >> 6, i = e & 63;
            const float inv = __builtin_amdgcn_exp2f(-(float)i * (13.287712379549449f / 64.0f));
            const float ang = (float)pos * inv;
            const float n = rintf(ang * 0.15915494309189535f);
            float r = fmaf(-n, 6.28125f, ang); r = fmaf(-n, 1.9353071795864769e-3f, r);
            rope[e] = (f32x2){__cosf(r), __sinf(r)};
        }
    }
    if (G > 96) { if (bid >= 96) convert_layer(p, ws, lds, 0, (bid - 96) * 8 + wave, (G - 96) * 8, wave, lane); }
    else convert_layer(p, ws, lds, 0, gw, NGW, wave, lane);
}

__device__ __forceinline__ void norm0_rows(const float* x, bf16_t* XN, const float* g, const float* mod0, float* ssq0, int bid, int G, int wave, int lane) {
    const int gw = bid * 8 + wave, NGW = G * 8;
    for (int m = gw; m < TOK; m += NGW) {
        const int b = m / SEQ;
        const f32x4* xr = (const f32x4*)(x + (size_t)m * DM) + lane;
        f32x4 v[4]; float s = 0.f;
#pragma unroll
        for (int j = 0; j < 4; ++j) { v[j] = xr[64 * j]; s += (v[j][0] * v[j][0] + v[j][1] * v[j][1]) + (v[j][2] * v[j][2] + v[j][3] * v[j][3]); }
#pragma unroll
        for (int o = 1; o < 64; o <<= 1) s += __shfl_xor(s, o);
        if (lane == 0) ssq0[m] = s;
        const float* mb = mod0 + (size_t)b * 6144;
        u32x2* o8 = (u32x2*)(XN + (size_t)m * DM) + lane;
#pragma unroll
        for (int j = 0; j < 4; ++j) {
            const int col = 4 * (lane + 64 * j);
            const f32x4 gg = *(const f32x4*)(g + col), sc = *(const f32x4*)(mb + 1024 + col);
            const f32x4 y = v[j] * gg * (sc + 1.0f);
            o8[64 * j] = (u32x2){pk2(y[0], y[1]), pk2(y[2], y[3])};
        }
    }
}
__device__ __forceinline__ void shw_items(const Ptrs& p, unsigned char* ws, LAS unsigned char* lds, int l_lo, int l_hi, int bid, int G, int tid, int wave, int lane) {
    const float* mod = (const float*)(ws + WS_MOD); float* shw = (float*)(ws + WS_SHW);
    int nit = 0;
    for (int l = l_lo; l < l_hi; ++l) nit += (l & 1) ? 34 : 36;
    for (int it = bid; it < nit; it += G) {
        int r = it, l = l_lo;
        for (;;) { const int nl = (l & 1) ? 34 : 36; if (r < nl) break; r -= nl; ++l; }
        const int nmix = (l & 1) ? 12 : 14, jl = l >> 1;
        const float* W; int ldw, which, cb, chunk;
        if (r < nmix) { which = 0; cb = r; chunk = 0; if (l & 1) { W = p.od_w_qkv + (size_t)jl * DM * 3 * DM; ldw = 3 * DM; } else { W = p.ev_w_in + (size_t)jl * DM * EVIN; ldw = EVIN; } }
        else if (r < nmix + 11) { which = 1; cb = r - nmix; chunk = 3; W = p.ffn_w_gate + (size_t)l * DM * DFF; ldw = DFF; }
        else { which = 2; cb = r - nmix - 11; chunk = 3; W = p.ffn_w_up + (size_t)l * DM * DFF; ldw = DFF; }
        gemv4_item(W + cb * 256, ldw, mod + (size_t)l * 4 * 6144 + chunk * 1024, 6144, false, shw + ((size_t)(l * 3 + which) * 4) * LDSHW + cb * 256, LDSHW, nullptr, lds, tid, wave, lane);
    }
}

constexpr int LP = 136;

__device__ __forceinline__ void rot8(const u32x4 a1, const u32x4 a2, const f32x2* rp, float fac, u32x4& o1, u32x4& o2) {
    float x1[8], x2[8], y1[8], y2[8];
#pragma unroll
    for (int i = 0; i < 4; ++i) { x1[2 * i] = bflo(a1[i]); x1[2 * i + 1] = bfhi(a1[i]); x2[2 * i] = bflo(a2[i]); x2[2 * i + 1] = bfhi(a2[i]); }
#pragma unroll
    for (int i = 0; i < 4; ++i) {
        const f32x4 cs = *(const f32x4*)(rp + 2 * i);
        y1[2 * i] = (x1[2 * i] * cs[0] - x2[2 * i] * cs[1]) * fac;          y2[2 * i] = (x1[2 * i] * cs[1] + x2[2 * i] * cs[0]) * fac;
        y1[2 * i + 1] = (x1[2 * i + 1] * cs[2] - x2[2 * i + 1] * cs[3]) * fac; y2[2 * i + 1] = (x1[2 * i + 1] * cs[3] + x2[2 * i + 1] * cs[2]) * fac;
    }
#pragma unroll
    for (int i = 0; i < 4; ++i) { o1[i] = pk2(y1[2 * i], y1[2 * i + 1]); o2[i] = pk2(y2[2 * i], y2[2 * i + 1]); }
}

#define GATHER8(dst, base, ROWEXPR, col) do { unsigned _w[4]; _Pragma("unroll") for (int _q = 0; _q < 4; ++_q) { \
        int jj = 2 * _q; const unsigned lo_ = (base)[(ROWEXPR) * LP + (col)]; jj = 2 * _q + 1; const unsigned hi_ = (base)[(ROWEXPR) * LP + (col)]; _w[_q] = lo_ | (hi_ << 16); } \
        dst = __builtin_bit_cast(bf16x8, (u32x4){_w[0], _w[1], _w[2], _w[3]}); } while (0)

__device__ __forceinline__ void evenA_phase(LAS unsigned char* lds, const bf16_t* PROJ, const f32x2* rope, float* KV, bf16_t* MIX, const float* conv_w,
                                            int bid, int G, int tid, int wave, int lane) {
    for (int it = bid; it < TOK / 64; it += G) {
        const int cs = 0, c = (tid & 63) * 8;
        const f32x4 wa0 = *(const f32x4*)(conv_w + c), wa1 = *(const f32x4*)(conv_w + c + 4);
        const f32x4 wb0 = *(const f32x4*)(conv_w + 512 + c), wb1 = *(const f32x4*)(conv_w + 512 + c + 4);
        const f32x4 wc0 = *(const f32x4*)(conv_w + 1024 + c), wc1 = *(const f32x4*)(conv_w + 1024 + c + 4);
#pragma unroll 2
        for (int q = 0; q < 8; ++q) {
            const int t = it * 64 + (tid >> 6) + 8 * q;
            const int tin = t % SEQ;
            const bf16_t* pr = PROJ + (size_t)t * EVIN;
            const u32x4 bg = *(const u32x4*)(pr + c), c0 = *(const u32x4*)(pr + 512 + c), u0 = *(const u32x4*)(pr + 1024 + c);
            u32x4 c1 = {0u, 0u, 0u, 0u}, u1 = c1, c2 = c1, u2 = c1;
            if (tin >= 1) { c1 = *(const u32x4*)(pr - EVIN + 512 + c); u1 = *(const u32x4*)(pr - EVIN + 1024 + c); }
            if (tin >= 2) { c2 = *(const u32x4*)(pr - 2 * EVIN + 512 + c); u2 = *(const u32x4*)(pr - 2 * EVIN + 1024 + c); }
            u32x4 o;
#pragma unroll
            for (int e = 0; e < 4; ++e) {
                const float w0l = e < 2 ? wa0[2 * e] : wa1[2 * e - 4], w0h = e < 2 ? wa0[2 * e + 1] : wa1[2 * e - 3];
                const float w1l = e < 2 ? wb0[2 * e] : wb1[2 * e - 4], w1h = e < 2 ? wb0[2 * e + 1] : wb1[2 * e - 3];
                const float w2l = e < 2 ? wc0[2 * e] : wc1[2 * e - 4], w2h = e < 2 ? wc0[2 * e + 1] : wc1[2 * e - 3];
                const float yl = w0l * (bflo(c2[e]) * bflo(u2[e])) + w1l * (bflo(c1[e]) * bflo(u1[e])) + w2l * (bflo(c0[e]) * bflo(u0[e]));
                const float yh = w0h * (bfhi(c2[e]) * bfhi(u2[e])) + w1h * (bfhi(c1[e]) * bfhi(u1[e])) + w2h * (bfhi(c0[e]) * bfhi(u0[e]));
                o[e] = pk2(bflo(bg[e]) * yl, bfhi(bg[e]) * yh);
            }
            *(u32x4*)(MIX + (size_t)t * DM + cs + c) = o;
        }
    }
    LAS bf16_t* Kl = (LAS bf16_t*)lds; LAS bf16_t* Vl = Kl + 64 * LP;
    const int l31 = lane & 31, hi = lane >> 5;
    for (int ui = bid; ui < 1024; ui += G) {
        const int b = ui >> 8, n = (ui >> 2) & 63, h = ui & 3;
        const int j = tid >> 3, c8 = tid & 7;
        const bf16_t* rowp = PROJ + (size_t)(b * SEQ + 64 * n + j) * EVIN + h * 128 + 8 * c8;
        const u32x4 k1 = *(const u32x4*)(rowp + 2048), k2 = *(const u32x4*)(rowp + 2048 + 64);
        const u32x4 v1 = *(const u32x4*)(rowp + 2560), v2 = *(const u32x4*)(rowp + 2560 + 64);
        const float fac = 0.08838834764831845f * __builtin_amdgcn_exp2f((float)(63 - j) * LOG2G[h]);
        u32x4 o1, o2; rot8(k1, k2, rope + (size_t)(64 * n + j) * 64 + 8 * c8, fac, o1, o2);
        *(LAS u32x4*)(Kl + j * LP + 8 * c8) = o1; *(LAS u32x4*)(Kl + j * LP + 64 + 8 * c8) = o2;
        *(LAS u32x4*)(Vl + j * LP + 8 * c8) = v1; *(LAS u32x4*)(Vl + j * LP + 64 + 8 * c8) = v2;
        WG_BARRIER();
        const int eblk = (wave & 3) * 32, dbase = (wave >> 2) * 64;
        f32x16 a0 = {}, a1 = {};
#pragma unroll
        for (int ks = 0; ks < 4; ++ks) {
            bf16x8 A, B0, B1;
            GATHER8(A, Vl, (16 * ks + 8 * hi + jj), eblk + l31);
            GATHER8(B0, Kl, (16 * ks + 8 * hi + jj), dbase + l31);
            GATHER8(B1, Kl, (16 * ks + 8 * hi + jj), dbase + 32 + l31);
            a0 = MFMA32(A, B0, a0); a1 = MFMA32(A, B1, a1);
        }
        bf16_t* kvp = (bf16_t*)KV + (size_t)ui * 16384 + dbase + l31;
#pragma unroll
        for (int r = 0; r < 16; ++r) { const int e = eblk + crow(r, hi); kvp[e * 128] = (bf16_t)(pk2(a0[r], 0.f) & 0xffffu); kvp[e * 128 + 32] = (bf16_t)(pk2(a1[r], 0.f) & 0xffffu); }
        WG_BARRIER();
    }
}

__device__ __forceinline__ void scan_phase(const float* KV, bf16_t* ST, int bid, int G, int tid) {
    for (int p = bid * 512 + tid; p < 16 * 8192; p += G * 512) {
        const int bh = p >> 13, idx = (p & 8191) * 2, b = bh >> 2, h = bh & 3;
        const float dec = DEC64[h];
        float s0 = 0.f, s1 = 0.f;
#pragma unroll 8
        for (int n = 0; n < 64; ++n) {
            const size_t off = (size_t)((b * 64 + n) * 4 + h) * 16384 + idx;
            const unsigned kvw = *(const unsigned*)((const bf16_t*)KV + off); const f32x2 kv = {bflo(kvw), bfhi(kvw)};
            *(unsigned*)(ST + off) = pk2(s0, s1);
            s0 = s0 * dec + kv[0]; s1 = s1 * dec + kv[1];
        }
    }
}

__device__ __forceinline__ void evenB_phase(LAS unsigned char* lds, const bf16_t* PROJ, const f32x2* rope, const bf16_t* ST, bf16_t* MIX, const float* retg,
                                            int bid, int G, int tid, int wave, int lane) {
    LAS bf16_t* Ql = (LAS bf16_t*)lds; LAS bf16_t* Kl = Ql + 64 * LP; LAS bf16_t* Vl = Kl + 64 * LP; LAS float* red = (LAS float*)(Vl + 64 * LP);
    const int l31 = lane & 31, hi = lane >> 5;
    for (int ui = bid; ui < 1024; ui += G) {
        const int b = ui >> 8, n = (ui >> 2) & 63, h = ui & 3;
        const float lg = LOG2G[h];
        {
            const int j = tid >> 3, c8 = tid & 7;
            const bf16_t* rowp = PROJ + (size_t)(b * SEQ + 64 * n + j) * EVIN + h * 128 + 8 * c8;
            const u32x4 q1 = *(const u32x4*)(rowp + 1536), q2 = *(const u32x4*)(rowp + 1536 + 64);
            const u32x4 k1 = *(const u32x4*)(rowp + 2048), k2 = *(const u32x4*)(rowp + 2048 + 64);
            const u32x4 v1 = *(const u32x4*)(rowp + 2560), v2 = *(const u32x4*)(rowp + 2560 + 64);
            const f32x2* rp = rope + (size_t)(64 * n + j) * 64 + 8 * c8;
            u32x4 o1, o2;
            rot8(q1, q2, rp, 1.0f, o1, o2);
            *(LAS u32x4*)(Ql + j * LP + 8 * c8) = o1; *(LAS u32x4*)(Ql + j * LP + 64 + 8 * c8) = o2;
            rot8(k1, k2, rp, 0.08838834764831845f, o1, o2);
            *(LAS u32x4*)(Kl + j * LP + 8 * c8) = o1; *(LAS u32x4*)(Kl + j * LP + 64 + 8 * c8) = o2;
            *(LAS u32x4*)(Vl + j * LP + 8 * c8) = v1; *(LAS u32x4*)(Vl + j * LP + 64 + 8 * c8) = v2;
        }
        WG_BARRIER();
        const int eblk = (wave & 3) * 32, iblk = (wave >> 2) * 32;
        f32x16 p0 = {}, p1 = {};
#pragma unroll
        for (int ks = 0; ks < 8; ++ks) {
            const bf16x8 kA0 = *(const LAS bf16x8*)(Kl + l31 * LP + 16 * ks + 8 * hi), kA1 = *(const LAS bf16x8*)(Kl + (32 + l31) * LP + 16 * ks + 8 * hi);
            const bf16x8 qB = *(const LAS bf16x8*)(Ql + (iblk + l31) * LP + 16 * ks + 8 * hi);
            p0 = MFMA32(kA0, qB, p0); p1 = MFMA32(kA1, qB, p1);
        }
        const int i = iblk + l31;
#pragma unroll
        for (int r = 0; r < 16; ++r) {
            const int j0 = crow(r, hi);
            const int d0 = i - j0, d1 = i - 32 - j0;
            p0[r] *= __builtin_amdgcn_exp2f((float)(d0 < 0 ? -d0 : d0) * lg);
            p1[r] *= __builtin_amdgcn_exp2f((float)(d1 < 0 ? -d1 : d1) * lg);
        }
        bf16x8 pk[4];
        pk[0] = __builtin_bit_cast(bf16x8, (u32x4){pk2(p0[0], p0[1]), pk2(p0[2], p0[3]), pk2(p0[4], p0[5]), pk2(p0[6], p0[7])});
        pk[1] = __builtin_bit_cast(bf16x8, (u32x4){pk2(p0[8], p0[9]), pk2(p0[10], p0[11]), pk2(p0[12], p0[13]), pk2(p0[14], p0[15])});
        pk[2] = __builtin_bit_cast(bf16x8, (u32x4){pk2(p1[0], p1[1]), pk2(p1[2], p1[3]), pk2(p1[4], p1[5]), pk2(p1[6], p1[7])});
        pk[3] = __builtin_bit_cast(bf16x8, (u32x4){pk2(p1[8], p1[9]), pk2(p1[10], p1[11]), pk2(p1[12], p1[13]), pk2(p1[14], p1[15])});
        f32x16 oi = {}, ox = {};
#pragma unroll
        for (int m = 0; m < 4; ++m) {
            bf16x8 A;
            GATHER8(A, Vl, (16 * m + (jj & 3) + 8 * (jj >> 2) + 4 * hi), eblk + l31);
            oi = MFMA32(A, pk[m], oi);
        }
        const bf16_t* stp = ST + (size_t)ui * 16384 + (size_t)(eblk + l31) * 128 + 8 * hi;
#pragma unroll
        for (int ks = 0; ks < 8; ++ks) {
            const bf16x8 A = *(const bf16x8*)(stp + 16 * ks);
            const bf16x8 qB = *(const LAS bf16x8*)(Ql + (iblk + l31) * LP + 16 * ks + 8 * hi);
            ox = MFMA32(A, qB, ox);
        }
        const float qd = __builtin_amdgcn_exp2f((float)(i + 1) * lg);
        float ss = 0.f;
#pragma unroll
        for (int r = 0; r < 16; ++r) { oi[r] += qd * ox[r]; ss += oi[r] * oi[r]; }
        ss += __shfl_xor(ss, 32);
        if (hi == 0) red[wave * 32 + l31] = ss;
        WG_BARRIER();
        const int wb = (wave >> 2) * 4;
        const float tot = (red[wb * 32 + l31] + red[(wb + 1) * 32 + l31]) + (red[(wb + 2) * 32 + l31] + red[(wb + 3) * 32 + l31]);
        const float rstd = __builtin_amdgcn_rsqf(tot * (1.0f / 128.0f) + EPS);
        const size_t t = (size_t)(b * SEQ + 64 * n + i);
#pragma unroll
        for (int g4 = 0; g4 < 4; ++g4) {
            const int e = eblk + 8 * g4 + 4 * hi;
            const u32x2 gw = *(const u32x2*)(PROJ + t * EVIN + 3072 + h * 128 + e);
            const f32x4 gn = *(const f32x4*)(retg + h * 128 + e);
            const float g0 = bflo(gw[0]), g1 = bfhi(gw[0]), g2 = bflo(gw[1]), g3 = bfhi(gw[1]);
            const float y0 = oi[4 * g4] * rstd * gn[0] * pg8::silu_f(g0), y1 = oi[4 * g4 + 1] * rstd * gn[1] * pg8::silu_f(g1);
            const float y2 = oi[4 * g4 + 2] * rstd * gn[2] * pg8::silu_f(g2), y3 = oi[4 * g4 + 3] * rstd * gn[3] * pg8::silu_f(g3);
            *(u32x2*)(MIX + t * DM + 512 + h * 128 + e) = (u32x2){pk2(y0, y1), pk2(y2, y3)};
        }
        WG_BARRIER();
    }
}

constexpr int VP = 72;
#define LDS_BARRIER() do { asm volatile("s_waitcnt lgkmcnt(0)" ::: "memory"); __builtin_amdgcn_s_barrier(); asm volatile("" ::: "memory"); } while (0)
__device__ __forceinline__ void attn_phase(LAS unsigned char* lds, const bf16_t* QK, const bf16_t* VT, bf16_t* MIX, const float* gq, const float* gk, int bid, int G, int tid, int wave, int lane) {
    LAS bf16_t* Kl = (LAS bf16_t*)lds; LAS bf16_t* Vtl = Kl + 64 * LP; LAS unsigned* flag = (LAS unsigned*)(Vtl + 128 * VP);
    const int l31 = lane & 31, hi = lane >> 5;
    const float qscale = 0.08838834764831845f * 1.4426950408889634f;
    const int krow = tid >> 4, kseg = tid & 15, vrow = tid >> 3, vseg = tid & 7;
    const int vcu = (G % 8 == 0) ? (bid % 8) * (G / 8) + bid / 8 : bid;
    for (int ui = vcu; ui < 512; ui += G) {
        const int qb = ui & 15, bh = ui >> 4, b = bh >> 3, h = bh & 7;
        const int q0 = qb * 256, rowbase = b * SEQ;
        const int qrow = q0 + 32 * wave + l31, qmax_w = q0 + 32 * wave + 31;
        const int jmax = 4 * qb + 3;
        const bf16_t* kgp = QK + (size_t)(rowbase + krow) * 2048 + 1024 + h * 128 + 8 * kseg;
        const bf16_t* vgp = VT + (size_t)(h * 128 + vrow) * TOK + rowbase + 8 * vseg;
        bf16x8 qf[8];
        {
            u32x4 qraw[8]; float ss = 0.f;
#pragma unroll
            for (int d0 = 0; d0 < 8; ++d0) { qraw[d0] = *(const u32x4*)(QK + (size_t)(rowbase + qrow) * 2048 + h * 128 + 16 * d0 + 8 * hi);
#pragma unroll
                for (int i = 0; i < 4; ++i) { const float a0 = bflo(qraw[d0][i]), a1 = bfhi(qraw[d0][i]); ss += a0 * a0 + a1 * a1; } }
            ss += __shfl_xor(ss, 32);
            const float rq = __builtin_amdgcn_rsqf(ss * (1.0f / 128.0f) + EPS) * qscale;
#pragma unroll
            for (int d0 = 0; d0 < 8; ++d0) {
                const f32x4 g0 = *(const f32x4*)(gq + 16 * d0 + 8 * hi), g1 = *(const f32x4*)(gq + 16 * d0 + 8 * hi + 4);
                u32x4 w;
                w[0] = pk2(bflo(qraw[d0][0]) * rq * g0[0], bfhi(qraw[d0][0]) * rq * g0[1]); w[1] = pk2(bflo(qraw[d0][1]) * rq * g0[2], bfhi(qraw[d0][1]) * rq * g0[3]);
                w[2] = pk2(bflo(qraw[d0][2]) * rq * g1[0], bfhi(qraw[d0][2]) * rq * g1[1]); w[3] = pk2(bflo(qraw[d0][3]) * rq * g1[2], bfhi(qraw[d0][3]) * rq * g1[3]);
                qf[d0] = __builtin_bit_cast(bf16x8, w);
            }
        }
        asm volatile("" ::: "memory");
        u32x4 kreg0 = *(const u32x4*)(kgp + (size_t)(64 * jmax) * 2048), kreg1 = *(const u32x4*)(kgp + (size_t)(64 * jmax + 32) * 2048);
        u32x4 vreg0 = *(const u32x4*)(vgp + 64 * jmax), vreg1 = *(const u32x4*)(vgp + (size_t)64 * TOK + 64 * jmax);
        f32x16 o[4];
#pragma unroll
        for (int d = 0; d < 4; ++d) o[d] = (f32x16){};
        float carry = 0.f; bool wdone = false;
        if (lane == 0) flag[wave] = 0u;
        for (int j = jmax; j >= 0; --j) {
            LDS_BARRIER();
            if (j != jmax) { unsigned all = 1u;
#pragma unroll
                for (int w = 0; w < 8; ++w) all &= flag[w];
                if (all) break; }
            const f32x4 gk0 = *(const f32x4*)(gk + 8 * kseg), gk1 = *(const f32x4*)(gk + 8 * kseg + 4);
#pragma unroll
            for (int i = 0; i < 2; ++i) {
                const u32x4 kr = i ? kreg1 : kreg0;
                float kf[8]; float ss = 0.f;
#pragma unroll
                for (int e = 0; e < 4; ++e) { kf[2 * e] = bflo(kr[e]); kf[2 * e + 1] = bfhi(kr[e]); ss += kf[2 * e] * kf[2 * e] + kf[2 * e + 1] * kf[2 * e + 1]; }
                ss += __shfl_xor(ss, 1); ss += __shfl_xor(ss, 2); ss += __shfl_xor(ss, 4); ss += __shfl_xor(ss, 8);
                const float rk = __builtin_amdgcn_rsqf(ss * (1.0f / 128.0f) + EPS);
                u32x4 w; w[0] = pk2(kf[0] * rk * gk0[0], kf[1] * rk * gk0[1]); w[1] = pk2(kf[2] * rk * gk0[2], kf[3] * rk * gk0[3]);
                w[2] = pk2(kf[4] * rk * gk1[0], kf[5] * rk * gk1[1]); w[3] = pk2(kf[6] * rk * gk1[2], kf[7] * rk * gk1[3]);
                *(LAS u32x4*)(Kl + (krow + 32 * i) * LP + 8 * kseg) = w;
                *(LAS u32x4*)(Vtl + (vrow + 64 * i) * VP + 8 * vseg) = i ? vreg1 : vreg0;
            }
            if (j > 0) {
                kreg0 = *(const u32x4*)(kgp + (size_t)(64 * (j - 1)) * 2048); kreg1 = *(const u32x4*)(kgp + (size_t)(64 * (j - 1) + 32) * 2048);
                vreg0 = *(const u32x4*)(vgp + 64 * (j - 1)); vreg1 = *(const u32x4*)(vgp + (size_t)64 * TOK + 64 * (j - 1));
            }
            LDS_BARRIER();
            if (!wdone && 64 * j <= qmax_w) {
                f32x16 p0 = {}, p1 = {};
#pragma unroll
                for (int d0 = 0; d0 < 8; ++d0) {
                    const bf16x8 kA0 = *(const LAS bf16x8*)(Kl + l31 * LP + 16 * d0 + 8 * hi), kA1 = *(const LAS bf16x8*)(Kl + (32 + l31) * LP + 16 * d0 + 8 * hi);
                    p0 = MFMA32(kA0, qf[d0], p0); p1 = MFMA32(kA1, qf[d0], p1);
                    if (d0 & 1) __builtin_amdgcn_sched_barrier(0);
                }
                const int keyb = 64 * j + 4 * hi;
                float run = carry;
#pragma unroll
                for (int pp = 1; pp >= 0; --pp) {
#pragma unroll
                    for (int g = 3; g >= 0; --g) {
                        float lk[4], lb[4];
#pragma unroll
                        for (int i = 0; i < 4; ++i) {
                            const float z = pp ? p1[4 * g + i] : p0[4 * g + i];
                            const bool valid = (keyb + 32 * pp + 8 * g + i) < qrow;
                            const float sp = fmaxf(z, 0.f) + __builtin_amdgcn_logf(1.0f + __builtin_amdgcn_exp2f(-fabsf(z)));
                            lk[i] = valid ? -sp : 0.f; lb[i] = valid ? (z - sp) : -__builtin_inff();
                        }
                        const float gs = (lk[0] + lk[1]) + (lk[2] + lk[3]);
                        const float pgs = __shfl_xor(gs, 32);
                        const float off = run + (hi == 0 ? pgs : 0.f);
                        const float A3 = off, A2 = off + lk[3], A1 = A2 + lk[2], A0 = A1 + lk[1];
                        const float w0 = __builtin_amdgcn_exp2f(lb[0] + A0), w1 = __builtin_amdgcn_exp2f(lb[1] + A1), w2 = __builtin_amdgcn_exp2f(lb[2] + A2), w3 = __builtin_amdgcn_exp2f(lb[3] + A3);
                        if (pp) { p1[4 * g] = w0; p1[4 * g + 1] = w1; p1[4 * g + 2] = w2; p1[4 * g + 3] = w3; }
                        else    { p0[4 * g] = w0; p0[4 * g + 1] = w1; p0[4 * g + 2] = w2; p0[4 * g + 3] = w3; }
                        run += gs + pgs;
                    }
                }
                carry = run;
                bf16x8 pk[4];
                pk[0] = __builtin_bit_cast(bf16x8, (u32x4){pk2(p0[0], p0[1]), pk2(p0[2], p0[3]), pk2(p0[4], p0[5]), pk2(p0[6], p0[7])});
                pk[1] = __builtin_bit_cast(bf16x8, (u32x4){pk2(p0[8], p0[9]), pk2(p0[10], p0[11]), pk2(p0[12], p0[13]), pk2(p0[14], p0[15])});
                pk[2] = __builtin_bit_cast(bf16x8, (u32x4){pk2(p1[0], p1[1]), pk2(p1[2], p1[3]), pk2(p1[4], p1[5]), pk2(p1[6], p1[7])});
                pk[3] = __builtin_bit_cast(bf16x8, (u32x4){pk2(p1[8], p1[9]), pk2(p1[10], p1[11]), pk2(p1[12], p1[13]), pk2(p1[14], p1[15])});
#pragma unroll
                for (int db = 0; db < 4; ++db)
#pragma unroll
                    for (int m = 0; m < 4; ++m) {
                        const LAS bf16_t* vp = Vtl + (32 * db + l31) * VP + 16 * m + 4 * hi;
                        const u32x2 lo = *(const LAS u32x2*)vp, hi2 = *(const LAS u32x2*)(vp + 8);
                        const bf16x8 vA = __builtin_bit_cast(bf16x8, (u32x4){lo[0], lo[1], hi2[0], hi2[1]});
                        o[db] = MFMA32(vA, pk[m], o[db]);
                        if (m == 3) __builtin_amdgcn_sched_barrier(0);
                    }
                wdone = __all(carry < -48.0f) != 0;
                if (lane == 0) flag[wave] = wdone ? 1u : 0u;
            }
        }
        bf16_t* op = MIX + (size_t)(rowbase + qrow) * DM + h * 128 + 4 * hi;
#pragma unroll
        for (int db = 0; db < 4; ++db)
#pragma unroll
            for (int g4 = 0; g4 < 4; ++g4)
                *(u32x2*)(op + 32 * db + 8 * g4) = (u32x2){pk2(o[db][4 * g4], o[db][4 * g4 + 1]), pk2(o[db][4 * g4 + 2], o[db][4 * g4 + 3])};
        WG_BARRIER();
    }
}

#define XB_TMO      128
#define XB_XCNT(j)  (256  + 64 * (j))
#define XB_XSUB(j)  (1280 + 64 * (j))
#define XB_XGEN(j)  (2304 + 64 * (j))
#define XB_TOP      3328
#define XB_TOPGEN   3392
#define XCD_BAR_WORDS 3456
#define XB_SPIN_CAP (1u << 18)

__device__ __forceinline__ unsigned xb_ld(unsigned* p)              { return __hip_atomic_load(p, __ATOMIC_RELAXED, __HIP_MEMORY_SCOPE_AGENT); }
__device__ __forceinline__ unsigned xb_add(unsigned* p, unsigned v) { return __hip_atomic_fetch_add(p, v, __ATOMIC_RELAXED, __HIP_MEMORY_SCOPE_AGENT); }
__device__ __forceinline__ unsigned xb_xcc_id() { return (unsigned)__builtin_amdgcn_s_getreg((3 << 11) | 20) & 0xFu; }
#define XB_SPIN(cond, bar) do { unsigned _sp = 0; while (cond) { __builtin_amdgcn_s_sleep(1); \
    if ((++_sp & 255u) == 0u) { if (xb_ld(&(bar)[XB_TMO])) break; if (_sp > XB_SPIN_CAP) { atomicAdd(&(bar)[XB_TMO], 1u); break; } } } } while (0)

struct XcdBarrier {
    unsigned* bar; unsigned x;
    volatile LAS unsigned* st;
};

__device__ __forceinline__ XcdBarrier xcd_barrier_post(unsigned* bar, volatile LAS unsigned* st, bool is_t0) {
    XcdBarrier b; b.bar = bar; b.x = xb_xcc_id(); b.st = st;
    if (is_t0) (void)xb_add(&bar[XB_XCNT(b.x)], 1u);
    return b;
}
__device__ __forceinline__ void xcd_barrier_complete(unsigned* bar, unsigned x, unsigned& nloc, unsigned& nx) {
    const unsigned G = gridDim.x * gridDim.y * gridDim.z;
    unsigned sum, cnt, mine, sp = 0u;
    for (;;) {
        sum = 0u; cnt = 0u; mine = 0u;
#pragma unroll
        for (unsigned j = 0; j < 16; ++j) { const unsigned c = xb_ld(&bar[XB_XCNT(j)]); sum += c; cnt += (c > 0u) ? 1u : 0u; mine = (j == x) ? c : mine; }
        if (sum == G) break;
        __builtin_amdgcn_s_sleep(1);
        if ((++sp & 255u) == 0u) { if (xb_ld(&bar[XB_TMO])) break; if (sp > XB_SPIN_CAP) { atomicAdd(&bar[XB_TMO], 1u); break; } }
    }
    nloc = mine > 0u ? mine : 1u; nx = cnt > 0u ? cnt : 1u;
}

__device__ __forceinline__ void xcd_barrier(const XcdBarrier& b, bool is_t0) {
    asm volatile("s_waitcnt vmcnt(0)" ::: "memory");
    __syncthreads();
    if (is_t0) {
        unsigned* bar = b.bar;
        __builtin_amdgcn_s_waitcnt(0);
        unsigned nloc = b.st[0], nx = b.st[1];
        if (nloc == 0u) { xcd_barrier_complete(bar, b.x, nloc, nx); b.st[0] = nloc; b.st[1] = nx; }
        const unsigned old = xb_add(&bar[XB_XSUB(b.x)], 1u);
        const unsigned gen = old / nloc;
        if (old + 1u == (gen + 1u) * nloc) {
            __builtin_amdgcn_fence(__ATOMIC_RELEASE, "agent");
            asm volatile("s_waitcnt vmcnt(0)" ::: "memory");
            const unsigned og = xb_add(&bar[XB_TOP], 1u);
            const unsigned tg = og / nx;
            if (og + 1u == (tg + 1u) * nx) xb_add(&bar[XB_TOPGEN], 1u);
            else XB_SPIN(xb_ld(&bar[XB_TOPGEN]) == tg, bar);
            __builtin_amdgcn_fence(__ATOMIC_ACQUIRE, "agent");
            xb_add(&bar[XB_XGEN(b.x)], 1u);
            asm volatile("s_waitcnt vmcnt(0)" ::: "memory");
        } else {
            XB_SPIN(xb_ld(&bar[XB_XGEN(b.x)]) == gen, bar);
            __builtin_amdgcn_fence(__ATOMIC_ACQUIRE, "agent");
            asm volatile("s_waitcnt vmcnt(0)" ::: "memory");
        }
    }
    __syncthreads();
}

constexpr size_t WS_BAR = 4096;
struct Args { const float* in[17]; float* out; unsigned char* ws; };
enum Phase { PH_PROLOGUE = 0, PH_P1, PH_GEMM_EVIN, PH_EVENA, PH_SCAN, PH_EVENB, PH_GEMM_QK, PH_GEMM_VT, PH_ATTN, PH_GEMM_OUT, PH_GEMM_GU, PH_GEMM_DN };

typedef const Args __attribute__((address_space(4)))* KArgs;
__device__ __forceinline__ int hw_lane() { int l; asm volatile("v_mbcnt_lo_u32_b32 %0, -1, 0\n\tv_mbcnt_hi_u32_b32 %0, -1, %0" : "=v"(l)); return l; }
template <int PH> __device__ __forceinline__ void run_phase(int l, LAS unsigned char* lds, int wave_s) {
    KArgs ap = (KArgs)__builtin_amdgcn_kernarg_segment_ptr();
    asm volatile("" : "+s"(ap));
    Args a;
#pragma unroll
    for (int i = 0; i < 17; ++i) a.in[i] = ap->in[i];
    a.out = ap->out; a.ws = ap->ws;
    int tid_ = wave_s * 64 + hw_lane(); asm volatile("" : "+v"(tid_));
    const int tid = tid_, lane = tid & 63, wave = __builtin_amdgcn_readfirstlane(tid >> 6);
    int bid_ = blockIdx.x; asm volatile("" : "+s"(bid_));
    const int bid = bid_, G = gridDim.x;
    unsigned char* ws = a.ws;
    float* out = a.out;
    const int jl = l >> 1;
    const float* modl = (const float*)(ws + WS_MOD) + (size_t)l * 4 * 6144;
    const f32x2* rope = (const f32x2*)(ws + WS_ROPE);
    bf16_t* XN = (bf16_t*)(ws + WS_XN); bf16_t* PROJ = (bf16_t*)(ws + WS_PROJ); bf16_t* MIX = (bf16_t*)(ws + WS_MIX);
    float* KV = (float*)(ws + WS_KV); bf16_t* ST = (bf16_t*)(ws + WS_ST);
    float* ssq = (float*)(ws + WS_SSQ);
    const float* shw = (const float*)(ws + WS_SHW) + (size_t)l * 3 * 4 * LDSHW;
    const float* xin = (l == 0) ? a.in[0] : out;
    if constexpr (PH == PH_PROLOGUE || PH == PH_P1) {
        Ptrs p;
        p.x = a.in[0]; p.c = a.in[1]; p.ada_w = a.in[2]; p.ada_b = a.in[3]; p.norm_mix_g = a.in[4]; p.norm_ffn_g = a.in[5]; p.ev_w_in = a.in[6]; p.ev_conv_w = a.in[7];
        p.ev_ret_norm_g = a.in[8]; p.ev_w_out = a.in[9]; p.od_w_qkv = a.in[10]; p.od_q_norm_g = a.in[11]; p.od_k_norm_g = a.in[12]; p.od_w_out = a.in[13];
        p.ffn_w_gate = a.in[14]; p.ffn_w_up = a.in[15]; p.ffn_w_down = a.in[16];
        if constexpr (PH == PH_PROLOGUE) prologue(p, ws, lds, bid, G, tid, wave, lane);
        else if (G > 36) {
            if (bid < 36) shw_items(p, ws, lds, 0, 1, bid, 36, tid, wave, lane); else norm0_rows(p.x, XN, p.norm_mix_g, (const float*)(ws + WS_MOD), ssq, bid - 36, G - 36, wave, lane);
        } else { norm0_rows(p.x, XN, p.norm_mix_g, (const float*)(ws + WS_MOD), ssq, bid, G, wave, lane); shw_items(p, ws, lds, 0, NL, bid, G, tid, wave, lane); }
    } else if constexpr (PH == PH_GEMM_EVIN) {
        pg8::Gemm g{XN, (const bf16_t*)(ws + W_EVIN) + (size_t)jl * EVIN * DM, TOK, EVIN, DM}; pg8::StaticOrder S; S.init(TOK, EVIN, G, bid);
        pg8::EpiScaleBias E{PROJ, EVIN, ssq + (size_t)(2 * l) * TOK, shw, LDSHW};
        pg8::gemm_phase<pg8::EpiScaleBias, pg8::StaticOrder, true, true>(lds, g, S, E, tid);
        if (G == 256 && bid >= 128) {
            Ptrs p;
            p.x = a.in[0]; p.c = a.in[1]; p.ada_w = a.in[2]; p.ada_b = a.in[3]; p.norm_mix_g = a.in[4]; p.norm_ffn_g = a.in[5]; p.ev_w_in = a.in[6]; p.ev_conv_w = a.in[7];
            p.ev_ret_norm_g = a.in[8]; p.ev_w_out = a.in[9]; p.od_w_qkv = a.in[10]; p.od_q_norm_g = a.in[11]; p.od_k_norm_g = a.in[12]; p.od_w_out = a.in[13];
            p.ffn_w_gate = a.in[14]; p.ffn_w_up = a.in[15]; p.ffn_w_down = a.in[16];
            if (l == 0) shw_items(p, ws, lds, 1, 3, bid - 128, 128, tid, wave, lane); else shw_items(p, ws, lds, 3, 4, bid - 128, 128, tid, wave, lane);
        }
    } else if constexpr (PH == PH_EVENA) {
        evenA_phase(lds, PROJ, rope, KV, MIX, a.in[7] + (size_t)jl * 3 * 512, bid, G, tid, wave, lane);
    } else if constexpr (PH == PH_SCAN) {
        scan_phase(KV, ST, bid, G, tid);
    } else if constexpr (PH == PH_EVENB) {
        evenB_phase(lds, PROJ, rope, ST, MIX, a.in[8] + jl * 512, bid, G, tid, wave, lane);
    } else if constexpr (PH == PH_GEMM_QK) {
        const bf16_t* wqkv_t = (const bf16_t*)(ws + W_ODQKV) + (size_t)jl * 3 * DM * DM;
        pg8::Gemm g{XN, wqkv_t, TOK, 2048, DM}; pg8::StaticOrder S; S.init(TOK, 2048, G, bid);
        pg8::EpiScaleBias E{PROJ, 2048, ssq + (size_t)(2 * l) * TOK, shw, LDSHW};
        pg8::gemm_phase<pg8::EpiScaleBias, pg8::StaticOrder, true, true>(lds, g, S, E, tid);
    } else if constexpr (PH == PH_GEMM_VT) {
        const bf16_t* wqkv_t = (const bf16_t*)(ws + W_ODQKV) + (size_t)jl * 3 * DM * DM;
        bf16_t* VT = PROJ + (size_t)TOK * 2048;
        pg8::Gemm g{wqkv_t + (size_t)2048 * DM, XN, DM, TOK, DM}; pg8::StaticOrder S; S.init(DM, TOK, G, bid);
        pg8::EpiScaleBiasT E{VT, TOK, ssq + (size_t)(2 * l) * TOK, shw + 2048, LDSHW};
        pg8::gemm_phase<pg8::EpiScaleBiasT, pg8::StaticOrder, true, true>(lds, g, S, E, tid);
    } else if constexpr (PH == PH_ATTN) {
        attn_phase(lds, PROJ, PROJ + (size_t)TOK * 2048, MIX, a.in[11] + jl * 128, a.in[12] + jl * 128, bid, G, tid, wave, lane);
    } else if constexpr (PH == PH_GEMM_OUT) {
        const bf16_t* wout_t = (l & 1) ? (const bf16_t*)(ws + W_ODOUT) + (size_t)jl * DM * DM : (const bf16_t*)(ws + W_EVOUT) + (size_t)jl * DM * DM;
        pg8::Gemm g{MIX, wout_t, TOK, DM, DM}; pg8::StaticOrder S; S.init(TOK, DM, G, bid);
        pg8::EpiResidNext E{xin, out, modl + 2 * 1024, XN, a.in[5] + l * DM, modl + 4 * 1024, ssq + (size_t)(2 * l + 1) * TOK, 1};
        pg8::gemm_phase<pg8::EpiResidNext, pg8::StaticOrder, true, true>(lds, g, S, E, tid);
    } else if constexpr (PH == PH_GEMM_GU) {
        pg8::Gemm g{XN, (const bf16_t*)(ws + W_GU) + (size_t)l * 2 * DFF * DM, TOK, 2 * DFF, DM}; pg8::StaticOrder S; S.init(TOK, 2 * DFF, G, bid);
        pg8::EpiSwiGLU E{PROJ, DFF, ssq + (size_t)(2 * l + 1) * TOK, shw + (size_t)4 * LDSHW, shw + (size_t)8 * LDSHW, LDSHW};
        pg8::gemm_phase<pg8::EpiSwiGLU, pg8::StaticOrder, true, true>(lds, g, S, E, tid);
        if (l + 1 < NL && G == 256 && bid >= 128) {
            Ptrs p;
            p.x = a.in[0]; p.c = a.in[1]; p.ada_w = a.in[2]; p.ada_b = a.in[3]; p.norm_mix_g = a.in[4]; p.norm_ffn_g = a.in[5]; p.ev_w_in = a.in[6]; p.ev_conv_w = a.in[7];
            p.ev_ret_norm_g = a.in[8]; p.ev_w_out = a.in[9]; p.od_w_qkv = a.in[10]; p.od_q_norm_g = a.in[11]; p.od_k_norm_g = a.in[12]; p.od_w_out = a.in[13];
            p.ffn_w_gate = a.in[14]; p.ffn_w_up = a.in[15]; p.ffn_w_down = a.in[16];
            convert_layer(p, ws, lds, l + 1, (bid - 128) * 8 + wave, 128 * 8, wave, lane);
        }
    } else if constexpr (PH == PH_GEMM_DN) {
        const int nxt = (l + 1 < NL) ? 1 : 0, ln = nxt ? l + 1 : l;
        pg8::Gemm g{PROJ, (const bf16_t*)(ws + W_DN) + (size_t)l * DM * DFF, TOK, DM, DFF}; pg8::StaticOrder S; S.init(TOK, DM, G, bid);
        pg8::EpiResidNext E{out, out, modl + 5 * 1024, XN, a.in[4] + ln * DM, (const float*)(ws + WS_MOD) + (size_t)ln * 4 * 6144 + 1024, ssq + (size_t)(2 * ln) * TOK, nxt};
        pg8::gemm_phase<pg8::EpiResidNext, pg8::StaticOrder, true, true>(lds, g, S, E, tid);
    }
}

__device__ __forceinline__ void seam(LAS unsigned char* lds, int wave_s) {
    KArgs ap = (KArgs)__builtin_amdgcn_kernarg_segment_ptr();
    asm volatile("" : "+s"(ap));
    XcdBarrier b; b.bar = (unsigned*)(ap->ws + WS_BAR); b.x = xb_xcc_id(); b.st = (volatile LAS unsigned*)(lds + LDS_EXTRA);
    xcd_barrier(b, wave_s == 0 && hw_lane() == 0);
}

__global__ void __launch_bounds__(512, 2) mk_fwd(Args a_unused) {
    extern __shared__ __attribute__((aligned(16))) unsigned char lds_raw[];
    cg::grid_group grid = cg::this_grid();
    LAS unsigned char* lds = (LAS unsigned char*)lds_raw;
    const int wave_s = __builtin_amdgcn_readfirstlane((int)threadIdx.x >> 6);
    if (wave_s == 0 && hw_lane() < 4) ((volatile LAS unsigned*)(lds + LDS_EXTRA))[hw_lane()] = 0u;
    if (blockIdx.x == 0) { KArgs a = (KArgs)__builtin_amdgcn_kernarg_segment_ptr(); unsigned* bw = (unsigned*)(a->ws + WS_BAR); for (int i = wave_s * 64 + hw_lane(); i < XCD_BAR_WORDS; i += 512) bw[i] = 0u; }
    run_phase<PH_PROLOGUE>(0, lds, wave_s);
    grid.sync();
    { KArgs ap = (KArgs)__builtin_amdgcn_kernarg_segment_ptr(); asm volatile("" : "+s"(ap)); (void)xcd_barrier_post((unsigned*)(ap->ws + WS_BAR), (volatile LAS unsigned*)(lds + LDS_EXTRA), wave_s == 0 && hw_lane() == 0); }
    run_phase<PH_P1>(0, lds, wave_s);
    seam(lds, wave_s);
#pragma unroll 1
    for (int l = 0; l < NL; ++l) {
        if ((l & 1) == 0) {
            run_phase<PH_GEMM_EVIN>(l, lds, wave_s);
            seam(lds, wave_s);
            run_phase<PH_EVENA>(l, lds, wave_s);
            seam(lds, wave_s);
            run_phase<PH_SCAN>(l, lds, wave_s);
            seam(lds, wave_s);
            run_phase<PH_EVENB>(l, lds, wave_s);
        } else {
            run_phase<PH_GEMM_QK>(l, lds, wave_s);
            run_phase<PH_GEMM_VT>(l, lds, wave_s);
            seam(lds, wave_s);
            run_phase<PH_ATTN>(l, lds, wave_s);
        }
        seam(lds, wave_s);
        run_phase<PH_GEMM_OUT>(l, lds, wave_s);
        seam(lds, wave_s);
        run_phase<PH_GEMM_GU>(l, lds, wave_s);
        seam(lds, wave_s);
        run_phase<PH_GEMM_DN>(l, lds, wave_s);
        if (l + 1 < NL) seam(lds, wave_s);
    }
}
}

extern "C" void kernel_launch(void* const* d_in, const int* in_sizes, int n_in, void* d_out, int out_size, void* d_ws, size_t ws_size, hipStream_t stream) {
    static int grid = 0;
    if (grid == 0) {
        if (n_in != 17 || out_size != mk::TOK * mk::DM || ws_size < mk::WS_END) { fprintf(stderr, "kernel_launch: unexpected shapes (n_in %d, out %d, ws %zu)\n", n_in, out_size, ws_size); grid = -1; return; }
        int dev = 0, cus = 0, per_cu = 0;
        (void)hipGetDevice(&dev); (void)hipDeviceGetAttribute(&cus, hipDeviceAttributeMultiprocessorCount, dev);
        if (hipFuncSetAttribute((const void*)mk::mk_fwd, hipFuncAttributeMaxDynamicSharedMemorySize, mk::LDS_BYTES) != hipSuccess) { fprintf(stderr, "kernel_launch: hipFuncSetAttribute failed\n"); grid = -1; return; }
        if (hipOccupancyMaxActiveBlocksPerMultiprocessor(&per_cu, (const void*)mk::mk_fwd, 512, mk::LDS_BYTES) != hipSuccess || per_cu < 1) fprintf(stderr, "kernel_launch: occupancy query says %d\n", per_cu);
        (void)hipGetLastError();
        grid = 256;
        if (cus != 256) fprintf(stderr, "kernel_launch: %d CUs reported, launching 256 workgroups\n", cus);
    }
    if (grid < 0) return;
    mk::Args a{};
    for (int i = 0; i < 17; ++i) a.in[i] = (const float*)d_in[i];
    a.out = (float*)d_out; a.ws = (unsigned char*)d_ws;
    void* args[] = {&a};
    hipError_t e = hipLaunchCooperativeKernel((const void*)mk::mk_fwd, dim3(grid), dim3(512), args, mk::LDS_BYTES, stream);
    if (e != hipSuccess) fprintf(stderr, "cooperative launch failed: %s (grid %d)\n", hipGetErrorString(e), grid);
}
```
